# Optimizing an MI355X kernel written in HIP

```python
import jax, jax.numpy as jnp
from jax import lax
import numpy as np

D_MODEL = 1024
BATCH = 4
SEQ = 4096
DEPTH = 1

CHUNK = 64
Q_BLOCK = 128
SB_HEADS = 8
SB_HEAD_DIM = 64
SB_WIDTH = SB_HEADS * SB_HEAD_DIM
CA_HEADS = 8
CA_HEAD_DIM = 64
CA_WIDTH = CA_HEADS * CA_HEAD_DIM
CA_LEFT_CHUNKS = 8
CA_BAND = (CA_LEFT_CHUNKS + 1) * CHUNK
REL_CLIP = 256
N_BRANCH = 2
PROJ_WIDTH = 3 * SB_WIDTH + 3 * CA_WIDTH
N_EXPERTS = 32
TOP_K = 4
D_EXPERT = D_MODEL
SWIGLU_ALPHA = 1.702
SWIGLU_LIMIT = 7.0
MOE_BLOCK = 128
RMS_EPS = 1e-6
N_MOD = 6

kernel_name = 'hybrid_stickbreak_chunkattn_moe_block'


def rms_norm(x, g):
    xf = x.astype(jnp.float32)
    y = xf * lax.rsqrt(jnp.mean(xf * xf, axis=-1, keepdims=True) + RMS_EPS)
    return (y * g.astype(jnp.float32)).astype(x.dtype)


def to_heads(t, n_heads):
    b, s, w = t.shape
    return t.reshape(b, s, n_heads, w // n_heads).transpose(0, 2, 1, 3)


def from_heads(t):
    b, h, s, dh = t.shape
    return t.transpose(0, 2, 1, 3).reshape(b, s, h * dh)


def stick_breaking_attention(q, k, v):
    b, h, s, d = q.shape
    n_blk = s // Q_BLOCK
    scale = d ** -0.5
    q_blocks = q.reshape(b, h, n_blk, Q_BLOCK, d).transpose(2, 0, 1, 3, 4)
    key_pos = jnp.arange(s)

    def one_block(args):
        q_blk, blk = args
        z = jnp.einsum('bhqd,bhkd->bhqk', q_blk, k).astype(jnp.float32) * scale
        q_pos = blk * Q_BLOCK + jnp.arange(Q_BLOCK)
        causal = key_pos[None, :] < q_pos[:, None]
        sp = jnp.where(causal, jax.nn.softplus(z), 0.0)
        between = lax.cumsum(sp, axis=3, reverse=True) - sp
        a = jnp.where(causal, jnp.exp(jax.nn.log_sigmoid(z) - between), 0.0)
        return jnp.einsum('bhqk,bhkd->bhqd', a.astype(v.dtype), v)

    o = lax.map(one_block, (q_blocks, jnp.arange(n_blk)))
    return o.transpose(1, 2, 0, 3, 4).reshape(b, h, s, d)


def chunked_band_attention(q, k, v, rel_bias):
    b, h, s, d = q.shape
    n_chunk = s // CHUNK
    pad = CA_LEFT_CHUNKS * CHUNK
    scale = d ** -0.5
    kp = jnp.pad(k, ((0, 0), (0, 0), (pad, 0), (0, 0)))
    vp = jnp.pad(v, ((0, 0), (0, 0), (pad, 0), (0, 0)))
    band_idx = jnp.arange(n_chunk)[:, None] * CHUNK + jnp.arange(CA_BAND)[None, :]
    k_band = kp[:, :, band_idx]
    v_band = vp[:, :, band_idx]
    q_chunk = q.reshape(b, h, n_chunk, CHUNK, d)
    z = jnp.einsum('bhcqd,bhckd->bhcqk', q_chunk, k_band).astype(jnp.float32) * scale
    rel = pad + jnp.arange(CHUNK)[:, None] - jnp.arange(CA_BAND)[None, :]
    bias = rel_bias[:, jnp.clip(rel, -REL_CLIP, REL_CLIP) + REL_CLIP]
    z = z + bias[None, :, None, :, :].astype(jnp.float32)
    valid = band_idx >= pad
    z = jnp.where(valid[None, None, :, None, :], z, -jnp.inf)
    p = jax.nn.softmax(z, axis=-1)
    o = jnp.einsum('bhcqk,bhckd->bhcqd', p.astype(v.dtype), v_band)
    return o.reshape(b, h, s, d)


def clamped_swiglu(hh):
    gate, up = jnp.split(hh, 2, axis=-1)
    gate = jnp.minimum(gate, SWIGLU_LIMIT)
    up = jnp.clip(up, -SWIGLU_LIMIT, SWIGLU_LIMIT)
    return gate * jax.nn.sigmoid(SWIGLU_ALPHA * gate) * (up + 1.0)


def moe_ffn(h, w_router, b_router, w1, b1, w2, b2):
    n, d = h.shape
    logits = (h @ w_router + b_router).astype(jnp.float32)
    top_logit, top_e = lax.top_k(logits, TOP_K)
    top_w = jax.nn.softmax(top_logit, axis=-1)
    nk = n * TOP_K
    flat_e = top_e.reshape(nk)
    flat_tok = jnp.arange(nk, dtype=jnp.int32) // TOP_K
    flat_w = top_w.reshape(nk)
    order = jnp.argsort(flat_e)
    sorted_e = flat_e[order]
    counts = jnp.bincount(flat_e, length=N_EXPERTS)
    padded = (counts + MOE_BLOCK - 1) // MOE_BLOCK * MOE_BLOCK
    pad_end = jnp.cumsum(padded)
    pad_start = pad_end - padded
    grp_start = jnp.cumsum(counts) - counts
    dest = pad_start[sorted_e] + jnp.arange(nk) - grp_start[sorted_e]
    n_blocks = -(-nk // MOE_BLOCK) + N_EXPERTS
    rows = n_blocks * MOE_BLOCK
    row_tok = jnp.zeros((rows,), jnp.int32).at[dest].set(flat_tok[order])
    row_w = jnp.zeros((rows,), jnp.float32).at[dest].set(flat_w[order])
    block_e = jnp.minimum(
        jnp.searchsorted(pad_end, jnp.arange(n_blocks) * MOE_BLOCK, side='right'), N_EXPERTS - 1)
    xs = h[row_tok].reshape(n_blocks, MOE_BLOCK, d)

    def expert_block(args):
        xb, e = args
        hid = clamped_swiglu(xb @ w1[e] + b1[e])
        return hid @ w2[e] + b2[e]

    ys = lax.map(expert_block, (xs, block_e)).reshape(rows, d)
    out = jax.ops.segment_sum(ys.astype(jnp.float32) * row_w[:, None], row_tok, num_segments=n)
    return out.astype(h.dtype)


def setup_inputs(seed: int = 0) -> dict:
    key = jax.random.key(seed)
    ks = jax.random.split(key, 24)
    L, D, E, I = DEPTH, D_MODEL, N_EXPERTS, D_EXPERT
    nrm = lambda k, shape, s: jax.random.normal(k, shape, jnp.float32) * s
    return {
        'x': nrm(ks[0], (BATCH, SEQ, D), 1.0),
        'c': nrm(ks[1], (BATCH, D), 1.0),
        'w_ada': nrm(ks[2], (L, D, N_MOD * D), 0.25 * D ** -0.5),
        'b_ada': nrm(ks[3], (L, N_MOD * D), 0.02),
        'g_pre_mix': 1.0 + nrm(ks[4], (L, D), 0.05),
        'g_post_mix': 1.0 + nrm(ks[5], (L, D), 0.05),
        'w_in': nrm(ks[6], (L, D, PROJ_WIDTH), D ** -0.5),
        'rel_bias': nrm(ks[7], (L, CA_HEADS, 2 * REL_CLIP + 1), 0.5),
        'w_branch_sb': nrm(ks[8], (L, SB_WIDTH, D), SB_WIDTH ** -0.5),
        'w_branch_ca': nrm(ks[9], (L, CA_WIDTH, D), CA_WIDTH ** -0.5),
        'w_gate': nrm(ks[10], (L, D, N_BRANCH * D), D ** -0.5),
        'b_gate': nrm(ks[11], (L, N_BRANCH * D), 0.02),
        'w_out': nrm(ks[12], (L, D, D), D ** -0.5),
        'g_pre_ffn': 1.0 + nrm(ks[13], (L, D), 0.05),
        'g_post_ffn': 1.0 + nrm(ks[14], (L, D), 0.05),
        'w_router': nrm(ks[15], (L, D, E), D ** -0.5),
        'b_router': nrm(ks[16], (L, E), 0.01),
        'w_e1': nrm(ks[17], (L, E, D, 2 * I), D ** -0.5),
        'b_e1': nrm(ks[18], (L, E, 2 * I), 0.02),
        'w_e2': nrm(ks[19], (L, E, I, D), I ** -0.5),
        'b_e2': nrm(ks[20], (L, E, D), 0.02),
    }


def reference(x, c, w_ada, b_ada, g_pre_mix, g_post_mix, w_in, rel_bias, w_branch_sb, w_branch_ca,
              w_gate, b_gate, w_out, g_pre_ffn, g_post_ffn, w_router, b_router, w_e1, b_e1, w_e2, b_e2):
    b, s, d = x.shape
    for l in range(DEPTH):
        mod = (c @ w_ada[l] + b_ada[l])[:, None, :]
        sh_m, sc_m, gt_m, sh_f, sc_f, gt_f = jnp.split(mod, N_MOD, axis=-1)

        h = rms_norm(x, g_pre_mix[l]) * (1.0 + sc_m) + sh_m
        proj = h @ w_in[l]
        q_sb, k_sb, v_sb, q_ca, k_ca, v_ca = jnp.split(proj, 6, axis=-1)
        o_sb = stick_breaking_attention(to_heads(q_sb, SB_HEADS), to_heads(k_sb, SB_HEADS),
                                        to_heads(v_sb, SB_HEADS))
        o_ca = chunked_band_attention(to_heads(q_ca, CA_HEADS), to_heads(k_ca, CA_HEADS),
                                      to_heads(v_ca, CA_HEADS), rel_bias[l])
        y_sb = from_heads(o_sb) @ w_branch_sb[l]
        y_ca = from_heads(o_ca) @ w_branch_ca[l]
        g_sb, g_ca = jnp.split(jax.nn.sigmoid(h @ w_gate[l] + b_gate[l]), N_BRANCH, axis=-1)
        mixed = (g_sb * y_sb + g_ca * y_ca) @ w_out[l]
        x = x + gt_m * rms_norm(mixed, g_post_mix[l])

        h2 = rms_norm(x, g_pre_ffn[l]) * (1.0 + sc_f) + sh_f
        ff = moe_ffn(h2.reshape(b * s, d), w_router[l], b_router[l], w_e1[l], b_e1[l],
                     w_e2[l], b_e2[l]).reshape(b, s, d)
        x = x + gt_f * rms_norm(ff, g_post_ffn[l])
    return x
```

```cpp
#include <hip/hip_runtime.h>
#include <hip/hip_bf16.h>
#include <cstdio>
#include <cstdint>

#ifndef MK_N_LAUNCHES
#define MK_N_LAUNCHES 1
#endif
#ifndef PROBE_REP
#define PROBE_REP -1
#endif

constexpr int D = 1024, BATCH = 4, SEQ = 4096, M = BATCH * SEQ;
constexpr int NCAT = 5120;
constexpr int NE = 32, TOPK = 4, CAP = 16384;
constexpr int MAXRB = M * TOPK / 256 + NE;
constexpr float RMS_EPS = 1e-6f;
constexpr float LOG2E = 1.4426950408889634f;
constexpr float QSCALE = 0.125f * LOG2E;

namespace pg8 {
#define PG8_LAS __attribute__((address_space(3)))
typedef unsigned short bf16_t;
typedef short bf16x8 __attribute__((ext_vector_type(8)));
typedef float f32x4 __attribute__((ext_vector_type(4)));
typedef float f32x2 __attribute__((ext_vector_type(2)));
typedef unsigned u32x4 __attribute__((ext_vector_type(4)));
constexpr int BM = 256, BK = 64, HALF = 128, HTB = HALF * BK * 2, STAGE_BYTES = 8 * HTB, NXCD = 8, WGM = 8;

__host__ __device__ __forceinline__ int lds_byte(int r, int c) { const int st = (r >> 4) * 2 + (c >> 5), rr = r & 15, cc = c & 31, ob = rr * 64 + cc * 2; return st * 1024 + (ob ^ (((ob >> 9) & 1) << 5)); }
__host__ __device__ __forceinline__ void stage_rc(int b, int& R, int& C) { const int st = b / 1024, sb = b % 1024, swz = sb ^ (((sb >> 9) & 1) << 5); R = (st >> 1) * 16 + swz / 64; C = (st & 1) * 32 + (swz % 64) / 2; }
__host__ __device__ __forceinline__ int perm32(int rho) { const int n = rho >> 4, i = rho & 15; return 8 * (i >> 2) + 4 * n + (i & 3); }

struct Unit { int arow0, brow0, ak0, bk0, x0, x1, x2, x3; };
struct Gemm { const bf16_t* A; const bf16_t* Bt; int lda, ldb, K; int hrowsB; };

__device__ __forceinline__ int xcd_remap(int L, int nwg) { const int q = nwg / NXCD, r = nwg % NXCD, xcd = L % NXCD, off = L / NXCD; return (xcd < r ? xcd * (q + 1) : r * (q + 1) + (xcd - r) * q) + off; }
__device__ __forceinline__ void tile_of(int wgid, int nM, int nN, int& pm, int& pn) {
    const int nig = WGM * nN, gid = wgid / nig, fm = gid * WGM, gsz = (nM - fm) < WGM ? (nM - fm) : WGM;
    pm = fm + ((wgid % nig) % gsz); pn = (wgid % nig) / gsz;
}
__device__ __forceinline__ unsigned cvt_pk_bf16(float lo, float hi) { typedef __bf16 bf16x2_t __attribute__((ext_vector_type(2))); f32x2 v = {lo, hi}; bf16x2_t b = __builtin_convertvector(v, bf16x2_t); return __builtin_bit_cast(unsigned, b); }
__device__ __forceinline__ float bf_lo(unsigned u) { return __uint_as_float(u << 16); }
__device__ __forceinline__ float bf_hi(unsigned u) { return __uint_as_float(u & 0xffff0000u); }
__device__ __forceinline__ unsigned cvt4_fp8(float a, float b, float c, float d) { int w = 0; w = __builtin_amdgcn_cvt_pk_fp8_f32(a, b, w, false); w = __builtin_amdgcn_cvt_pk_fp8_f32(c, d, w, true); return (unsigned)w; }
constexpr float W8_SCALE = 64.0f, W8_INV = 1.0f / 64.0f;
__device__ __forceinline__ float sigmoidf_fast(float x) { return __builtin_amdgcn_rcpf(1.0f + __builtin_amdgcn_exp2f(-x * LOG2E)); }

struct PlainOrder {
    int nM, nN, G, c, bmul;
    __device__ __forceinline__ bool next(int i, Unit& u) const {
        const int nwg = nM * nN; const long L = (long)i * G + c; if (L >= nwg) return false;
        int pm, pn; tile_of(xcd_remap((int)L, nwg), nM, nN, pm, pn);
        u.arow0 = pm * BM; u.brow0 = pn * bmul; u.ak0 = 0; u.bk0 = 0; u.x0 = 0; u.x1 = pm * BM; u.x2 = pn * bmul; u.x3 = 0; return true;
    }
    __device__ __forceinline__ unsigned aoff(const Unit& u, int h, int R, int C, int lda) const { return (unsigned)(((u.arow0 + HALF * h + R) * lda + u.ak0 + C) * 2); }
};
template <bool GATHER> struct MoeOrder {
    const PG8_LAS int* tab; const int* rowtok; int npn, G, c;
    __device__ __forceinline__ bool next(int i, Unit& u) const {
        const int nrb = tab[32]; const int nwg = nrb * npn; const long L = (long)i * G + c; if (L >= nwg) return false;
        const int wg = xcd_remap((int)L, nwg); const int rbg = wg / npn, pn = wg % npn;
        int e = 0;
#pragma unroll
        for (int j = 1; j < 32; ++j) e += (rbg >= tab[j]) ? 1 : 0;
        e = __builtin_amdgcn_readfirstlane(e);
        const int rb = __builtin_amdgcn_readfirstlane(rbg - tab[e]); const int prow0 = __builtin_amdgcn_readfirstlane(tab[40 + e] + rb * BM);
        u.x0 = e; u.x1 = prow0; u.x2 = pn; u.x3 = rb * BM; u.arow0 = prow0; u.brow0 = (e * npn + pn) * BM; u.ak0 = 0; u.bk0 = 0; return true;
    }
    __device__ __forceinline__ unsigned aoff(const Unit& u, int h, int R, int C, int lda) const {
        if constexpr (GATHER) { const int r = u.x3 + HALF * h + R; const int cnt = tab[80 + u.x0]; int tok = 0; if (r < cnt) tok = rowtok[u.x0 * CAP + r]; return (unsigned)((tok * lda + C) * 2); }
        else return (unsigned)(((u.arow0 + HALF * h + R) * lda + C) * 2);
    }
};

struct EpiProj {
    static constexpr bool PERM = true; bf16_t* QKV; bf16_t* GATE; const float* bgate;
    __device__ __forceinline__ void operator()(const f32x4 (&acc)[2][2][4][2], const Unit& u, int wr, int wc, int fr, int fq) const {
        const int row0 = u.x1 + wr * 64 + fr, colt = u.x2, col0 = colt + wc * 32 + 8 * fq;
        const int mode = (colt >= 3072) ? 2 : ((colt < 512 || (colt >= 1536 && colt < 2048)) ? 1 : 0);
        f32x4 bv[2][2];
#pragma unroll
        for (int bj = 0; bj < 2; ++bj)
#pragma unroll
            for (int n = 0; n < 2; ++n) bv[bj][n] = (mode == 2) ? *(const f32x4*)(bgate + (col0 - 3072) + bj * HALF + 4 * n) : (f32x4){0.f, 0.f, 0.f, 0.f};
        const int bb = row0 / SEQ, s0 = row0 % SEQ;
#pragma unroll
        for (int ai = 0; ai < 2; ++ai)
#pragma unroll
            for (int m = 0; m < 4; ++m) { const int srow = s0 + ai * HALF + m * 16;
#pragma unroll
                for (int bj = 0; bj < 2; ++bj) { f32x4 v0 = acc[ai][bj][m][0], v1 = acc[ai][bj][m][1]; const int col = col0 + bj * HALF;
                    if (mode == 2) { v0 += bv[bj][0]; v1 += bv[bj][1];
#pragma unroll
                        for (int k = 0; k < 4; ++k) { v0[k] = sigmoidf_fast(v0[k]); v1[k] = sigmoidf_fast(v1[k]); } }
                    else if (mode == 1) { v0 = v0 * QSCALE; v1 = v1 * QSCALE; }
                    u32x4 w; w.x = cvt_pk_bf16(v0[0], v0[1]); w.y = cvt_pk_bf16(v0[2], v0[3]); w.z = cvt_pk_bf16(v1[0], v1[1]); w.w = cvt_pk_bf16(v1[2], v1[3]);
                    if (mode == 2) __builtin_nontemporal_store(w, (u32x4*)(GATE + (size_t)(bb * SEQ + srow) * 2048 + (col - 3072)));
                    else { const int kind = col >> 9, hh = (col >> 6) & 7, d = col & 63; *(u32x4*)(QKV + ((size_t)((kind * BATCH + bb) * 8 + hh) * SEQ + srow) * 64 + d) = w; } } }
    }
};
struct EpiMix2 {
    static constexpr bool PERM = true; const bf16_t* GATE; bf16_t* O;
    __device__ __forceinline__ void operator()(const f32x4 (&acc)[2][2][4][2], const Unit& u, int wr, int wc, int fr, int fq) const {
        const int row0 = u.x1 + wr * 64 + fr, col0 = u.x2 + wc * 32 + 8 * fq;
#pragma unroll
        for (int ai = 0; ai < 2; ++ai)
#pragma unroll
            for (int m = 0; m < 4; ++m) { const size_t row = (size_t)(row0 + ai * HALF + m * 16);
                const u32x4 gs = __builtin_nontemporal_load((const u32x4*)(GATE + row * 2048 + col0)), gc = __builtin_nontemporal_load((const u32x4*)(GATE + row * 2048 + 1024 + col0));
                const f32x4 a0 = acc[ai][0][m][0], a1 = acc[ai][0][m][1], c0 = acc[ai][1][m][0], c1 = acc[ai][1][m][1];
                u32x4 w;
                w.x = cvt_pk_bf16(a0[0] * bf_lo(gs.x) + c0[0] * bf_lo(gc.x), a0[1] * bf_hi(gs.x) + c0[1] * bf_hi(gc.x));
                w.y = cvt_pk_bf16(a0[2] * bf_lo(gs.y) + c0[2] * bf_lo(gc.y), a0[3] * bf_hi(gs.y) + c0[3] * bf_hi(gc.y));
                w.z = cvt_pk_bf16(a1[0] * bf_lo(gs.z) + c1[0] * bf_lo(gc.z), a1[1] * bf_hi(gs.z) + c1[1] * bf_hi(gc.z));
                w.w = cvt_pk_bf16(a1[2] * bf_lo(gs.w) + c1[2] * bf_lo(gc.w), a1[3] * bf_hi(gs.w) + c1[3] * bf_hi(gc.w));
                *(u32x4*)(O + row * D + col0) = w; }
    }
};
struct EpiStore {
    static constexpr bool PERM = true; bf16_t* O; int ldc; const float* bias; int colmul; int bias_ld; float scale; int out8;
    __device__ __forceinline__ void operator()(const f32x4 (&acc)[2][2][4][2], const Unit& u, int wr, int wc, int fr, int fq) const {
        const int row0 = u.x1 + wr * 64 + fr, col0 = u.x2 * colmul + wc * 32 + 8 * fq;
        f32x4 bv[2][2];
#pragma unroll
        for (int bj = 0; bj < 2; ++bj)
#pragma unroll
            for (int n = 0; n < 2; ++n) bv[bj][n] = bias ? *(const f32x4*)(bias + (size_t)u.x0 * bias_ld + col0 + bj * HALF + 4 * n) : (f32x4){0.f, 0.f, 0.f, 0.f};
#pragma unroll
        for (int ai = 0; ai < 2; ++ai)
#pragma unroll
            for (int m = 0; m < 4; ++m) { bf16_t* rowp = O + (size_t)(row0 + ai * HALF + m * 16) * ldc + col0;
#pragma unroll
                for (int bj = 0; bj < 2; ++bj) { const f32x4 v0 = acc[ai][bj][m][0] * scale + bv[bj][0], v1 = acc[ai][bj][m][1] * scale + bv[bj][1];
                    if (out8) { typedef unsigned u32x2 __attribute__((ext_vector_type(2))); u32x2 w8; w8.x = cvt4_fp8(v0[0], v0[1], v0[2], v0[3]); w8.y = cvt4_fp8(v1[0], v1[1], v1[2], v1[3]);
                        *(u32x2*)((unsigned char*)O + (size_t)(row0 + ai * HALF + m * 16) * ldc + col0 + bj * HALF) = w8; continue; }
                    u32x4 w; w.x = cvt_pk_bf16(v0[0], v0[1]); w.y = cvt_pk_bf16(v0[2], v0[3]); w.z = cvt_pk_bf16(v1[0], v1[1]); w.w = cvt_pk_bf16(v1[2], v1[3]);
                    *(u32x4*)(rowp + bj * HALF) = w; } }
    }
};
struct EpiSwiglu {
    static constexpr bool PERM = true; unsigned char* O; const float* b1;
    __device__ __forceinline__ void operator()(const f32x4 (&acc)[2][2][4][2], const Unit& u, int wr, int wc, int fr, int fq) const {
        const int row0 = u.x1 + wr * 64 + fr, col0 = u.x2 * HALF + wc * 32 + 8 * fq;
        const float* bb = b1 + (size_t)u.x0 * 2048 + col0;
        f32x4 bg[2], bu[2];
#pragma unroll
        for (int n = 0; n < 2; ++n) { bg[n] = *(const f32x4*)(bb + 4 * n); bu[n] = *(const f32x4*)(bb + 1024 + 4 * n); }
#pragma unroll
        for (int ai = 0; ai < 2; ++ai)
#pragma unroll
            for (int m = 0; m < 4; ++m) { unsigned char* rowp = O + (size_t)(row0 + ai * HALF + m * 16) * D + col0; f32x4 o[2];
#pragma unroll
                for (int n = 0; n < 2; ++n) { const f32x4 g = acc[ai][0][m][n] * W8_INV + bg[n], up = acc[ai][1][m][n] * W8_INV + bu[n];
#pragma unroll
                    for (int k = 0; k < 4; ++k) { const float gg = fminf(g[k], 7.0f), uu = fminf(fmaxf(up[k], -7.0f), 7.0f);
                        o[n][k] = gg * __builtin_amdgcn_rcpf(1.0f + __builtin_amdgcn_exp2f(-1.702f * LOG2E * gg)) * (uu + 1.0f); } }
                typedef unsigned u32x2 __attribute__((ext_vector_type(2)));
                u32x2 w; w.x = cvt4_fp8(o[0][0], o[0][1], o[0][2], o[0][3]); w.y = cvt4_fp8(o[1][0], o[1][1], o[1][2], o[1][3]);
                *(u32x2*)rowp = w; }
    }
};

typedef int v8i __attribute__((ext_vector_type(8)));
template <class Epi, class Sched, int MODE = 0>
__device__ __forceinline__ void gemm_phase(PG8_LAS unsigned char* lds, const Gemm g, const Sched& S, const Epi& E) {
    constexpr bool FP8 = (MODE == 1);
    const int tid = threadIdx.x, wid = __builtin_amdgcn_readfirstlane(tid >> 6), lane = tid & 63, wr = wid >> 2, wc = wid & 3, fr = lane & 15, fq = lane >> 4;
    const int nt = g.K / BK;
    int Rs[2], Cs[2]; unsigned voffB[2];
#pragma unroll
    for (int i = 0; i < 2; ++i) { stage_rc(tid * 16 + i * 8192, Rs[i], Cs[i]); const int Rb = Epi::PERM ? ((Rs[i] & ~31) + perm32(Rs[i] & 31)) : Rs[i]; voffB[i] = (unsigned)(Rb * g.ldb + Cs[i]) * 2u; }
    const size_t kstep = (size_t)(BK * 2);
    const size_t hstepB = (size_t)g.hrowsB * g.ldb * 2;
    const unsigned ldsw = (unsigned)wid * 1024u;
    const int aoff = FP8 ? lds_byte(wr * 64 + fr, 32 * (fq >> 1) + 16 * (fq & 1)) : lds_byte(wr * 64 + fr, fq * 8), boff = FP8 ? lds_byte(wc * 32 + fr, 32 * (fq >> 1) + 16 * (fq & 1)) : lds_byte(wc * 32 + fr, fq * 8);
#define PG8_SA(b, h) (((b) * 2 + (h)) * HTB)
#define PG8_SB(b, h) ((4 + (b) * 2 + (h)) * HTB)
#define PG8_STAGE(bufoff, gbase, voff) do { _Pragma("unroll") for (int _i = 0; _i < 2; ++_i) \
        __builtin_amdgcn_global_load_lds((const unsigned*)((const char*)(gbase) + (voff)[_i]), (PG8_LAS unsigned*)(lds + (bufoff) + ldsw + _i * 8192), 16, 0, 0); } while (0)
#define PG8_LDA(dst, b, h) do { _Pragma("unroll") for (int m = 0; m < 4; ++m) _Pragma("unroll") for (int k = 0; k < 2; ++k) dst[m][k] = *(const PG8_LAS bf16x8*)(lds + PG8_SA(b, h) + aoff + m * 2048 + k * 1024); } while (0)
#define PG8_LDB(dst, b, h) do { _Pragma("unroll") for (int n = 0; n < 2; ++n) _Pragma("unroll") for (int k = 0; k < 2; ++k) dst[n][k] = *(const PG8_LAS bf16x8*)(lds + PG8_SB(b, h) + boff + n * 2048 + k * 1024); } while (0)
#define PG8_MMA(ai, bj, At, Bt) do { __builtin_amdgcn_s_setprio(1); _Pragma("unroll") for (int m = 0; m < 4; ++m) _Pragma("unroll") for (int n = 0; n < 2; ++n) _Pragma("unroll") for (int k = 0; k < 2; ++k) \
        acc[ai][bj][m][n] = __builtin_amdgcn_mfma_f32_16x16x32_bf16(Bt[n][k], At[m][k], acc[ai][bj][m][n], 0, 0, 0); __builtin_amdgcn_s_setprio(0); } while (0)
#define PG8_LDA8(dst, b, h) do { _Pragma("unroll") for (int m = 0; m < 4; ++m) { const u32x4 lo_ = *(const PG8_LAS u32x4*)(lds + PG8_SA(b, h) + aoff + m * 2048), hi_ = *(const PG8_LAS u32x4*)(lds + PG8_SA(b, h) + aoff + m * 2048 + 16); \
        dst[m] = (v8i){(int)lo_.x, (int)lo_.y, (int)lo_.z, (int)lo_.w, (int)hi_.x, (int)hi_.y, (int)hi_.z, (int)hi_.w}; } } while (0)
#define PG8_LDB8(dst, b, h) do { _Pragma("unroll") for (int n = 0; n < 2; ++n) { const u32x4 lo_ = *(const PG8_LAS u32x4*)(lds + PG8_SB(b, h) + boff + n * 2048), hi_ = *(const PG8_LAS u32x4*)(lds + PG8_SB(b, h) + boff + n * 2048 + 16); \
        dst[n] = (v8i){(int)lo_.x, (int)lo_.y, (int)lo_.z, (int)lo_.w, (int)hi_.x, (int)hi_.y, (int)hi_.z, (int)hi_.w}; } } while (0)
#define PG8_MMA8(ai, bj, At, Bt) do { asm volatile("" : "+v"(At[0]), "+v"(At[1]), "+v"(At[2]), "+v"(At[3]), "+v"(Bt[0]), "+v"(Bt[1])); \
        __builtin_amdgcn_s_setprio(1); _Pragma("unroll") for (int m = 0; m < 4; ++m) _Pragma("unroll") for (int n = 0; n < 2; ++n) \
        acc[ai][bj][m][n] = __builtin_amdgcn_mfma_scale_f32_16x16x128_f8f6f4(Bt[n], At[m], acc[ai][bj][m][n], 0, 0, 0, 0x7F7F7F7F, 0, 0x7F7F7F7F); \
        asm volatile("" : "+v"(acc[ai][bj][0][0]), "+v"(acc[ai][bj][0][1]), "+v"(acc[ai][bj][1][0]), "+v"(acc[ai][bj][1][1]), "+v"(acc[ai][bj][2][0]), "+v"(acc[ai][bj][2][1]), "+v"(acc[ai][bj][3][0]), "+v"(acc[ai][bj][3][1])); \
        __builtin_amdgcn_s_setprio(0); } while (0)
#define PG8_WAIT_V(n) asm volatile("s_waitcnt vmcnt(" #n ")" ::: "memory")
#define PG8_WAIT_L(n) asm volatile("s_waitcnt lgkmcnt(" #n ")" ::: "memory")
#define PG8_BAR __builtin_amdgcn_s_barrier()
#define PG8_SCHED __builtin_amdgcn_sched_barrier(0)
    Unit cur, nxt; int ui = 0;
    if (!S.next(0, cur)) return;
    f32x4 acc[2][2][4][2];
#pragma unroll
    for (int a = 0; a < 2; ++a)
#pragma unroll
        for (int b = 0; b < 2; ++b)
#pragma unroll
            for (int m = 0; m < 4; ++m)
#pragma unroll
                for (int n = 0; n < 2; ++n) acc[a][b][m][n] = (f32x4){0.f, 0.f, 0.f, 0.f};
    bf16x8 At[4][2], B0[2][2], B1[2][2];
    v8i At8[4], B08[2], B18[2];
    unsigned vc[2][2], vn[2][2];
#pragma unroll
    for (int h = 0; h < 2; ++h)
#pragma unroll
        for (int i = 0; i < 2; ++i) vc[h][i] = S.aoff(cur, h, Rs[i], Cs[i], g.lda);
    const char* const cA = (const char*)g.A;
    const char* cB = (const char*)g.Bt + ((size_t)cur.brow0 * g.ldb + cur.bk0) * 2;
    PG8_STAGE(PG8_SB(0, 0), cB, voffB); PG8_STAGE(PG8_SB(0, 1), cB + hstepB, voffB); PG8_STAGE(PG8_SA(0, 0), cA, vc[0]); PG8_STAGE(PG8_SA(0, 1), cA, vc[1]);
    if (wr == 1) PG8_BAR;
    PG8_WAIT_V(2); PG8_BAR;
    PG8_STAGE(PG8_SB(1, 0), cB + kstep, voffB); PG8_STAGE(PG8_SA(1, 0), cA + kstep, vc[0]); PG8_STAGE(PG8_SB(1, 1), cB + hstepB + kstep, voffB);
    PG8_WAIT_V(6); PG8_BAR;
    for (;;) {
        const bool has_next = S.next(ui + 1, nxt);
        const char* nB = cB;
        if (has_next) { nB = (const char*)g.Bt + ((size_t)nxt.brow0 * g.ldb + nxt.bk0) * 2;
#pragma unroll
            for (int h = 0; h < 2; ++h)
#pragma unroll
                for (int i = 0; i < 2; ++i) vn[h][i] = S.aoff(nxt, h, Rs[i], Cs[i], g.lda);
        } else {
#pragma unroll
            for (int h = 0; h < 2; ++h)
#pragma unroll
                for (int i = 0; i < 2; ++i) vn[h][i] = vc[h][i];
        }
        for (int t = 0; t < nt; t += 2) {
            const bool last = (t == nt - 2);
            const char* a1 = cA + (size_t)(t + 1) * kstep;
            const char* a2 = last ? cA : cA + (size_t)(t + 2) * kstep; const char* b2 = last ? nB : cB + (size_t)(t + 2) * kstep;
            const char* a3 = a2 + kstep; const char* b3 = b2 + kstep;
            unsigned w0[2], w1[2];
            w0[0] = last ? vn[0][0] : vc[0][0]; w0[1] = last ? vn[0][1] : vc[0][1]; w1[0] = last ? vn[1][0] : vc[1][0]; w1[1] = last ? vn[1][1] : vc[1][1];
            if constexpr (MODE == 2) {
            const bool first = t < (nt >> 1);
            PG8_LDB(B0, 0, 0); PG8_SCHED; PG8_LDA(At, 0, 0); PG8_STAGE(PG8_SA(1, 1), a1, vc[1]);
            PG8_WAIT_V(8); PG8_WAIT_L(0); PG8_BAR; if (first) { PG8_MMA(0, 0, At, B0); } else { PG8_MMA(0, 1, At, B0); } PG8_BAR; PG8_SCHED;
            PG8_LDA(At, 0, 1); PG8_STAGE(PG8_SB(0, 0), b2, voffB); PG8_STAGE(PG8_SB(0, 1), b2 + hstepB, voffB); PG8_STAGE(PG8_SA(0, 0), a2, w0);
            PG8_WAIT_V(8); PG8_WAIT_L(0); PG8_BAR; if (first) { PG8_MMA(1, 0, At, B0); } else { PG8_MMA(1, 1, At, B0); } PG8_BAR; PG8_SCHED;
            PG8_LDB(B0, 1, 0); PG8_SCHED; PG8_LDA(At, 1, 0); PG8_STAGE(PG8_SA(0, 1), a2, w1);
            PG8_WAIT_V(8); PG8_WAIT_L(0); PG8_BAR; if (first) { PG8_MMA(0, 0, At, B0); } else { PG8_MMA(0, 1, At, B0); } PG8_BAR; PG8_SCHED;
            PG8_LDA(At, 1, 1); PG8_STAGE(PG8_SB(1, 0), b3, voffB); PG8_STAGE(PG8_SB(1, 1), b3 + hstepB, voffB); PG8_STAGE(PG8_SA(1, 0), a3, w0);
            PG8_WAIT_V(8); PG8_WAIT_L(0); PG8_BAR; if (first) { PG8_MMA(1, 0, At, B0); } else { PG8_MMA(1, 1, At, B0); } PG8_BAR; PG8_SCHED;
            } else if constexpr (!FP8) {
            PG8_LDB(B0, 0, 0); PG8_LDB(B1, 0, 1); PG8_SCHED; PG8_LDA(At, 0, 0); PG8_STAGE(PG8_SA(1, 1), a1, vc[1]);
            PG8_WAIT_V(8); PG8_WAIT_L(0); PG8_BAR; PG8_MMA(0, 0, At, B0); PG8_MMA(0, 1, At, B1); PG8_BAR; PG8_SCHED;
            PG8_LDA(At, 0, 1); PG8_STAGE(PG8_SB(0, 0), b2, voffB); PG8_STAGE(PG8_SB(0, 1), b2 + hstepB, voffB); PG8_STAGE(PG8_SA(0, 0), a2, w0);
            PG8_WAIT_V(8); PG8_WAIT_L(0); PG8_BAR; PG8_MMA(1, 0, At, B0); PG8_MMA(1, 1, At, B1); PG8_BAR; PG8_SCHED;
            PG8_LDB(B0, 1, 0); PG8_LDB(B1, 1, 1); PG8_SCHED; PG8_LDA(At, 1, 0); PG8_STAGE(PG8_SA(0, 1), a2, w1);
            PG8_WAIT_V(8); PG8_WAIT_L(0); PG8_BAR; PG8_MMA(0, 0, At, B0); PG8_MMA(0, 1, At, B1); PG8_BAR; PG8_SCHED;
            PG8_LDA(At, 1, 1); PG8_STAGE(PG8_SB(1, 0), b3, voffB); PG8_STAGE(PG8_SB(1, 1), b3 + hstepB, voffB); PG8_STAGE(PG8_SA(1, 0), a3, w0);
            PG8_WAIT_V(8); PG8_WAIT_L(0); PG8_BAR; PG8_MMA(1, 0, At, B0); PG8_MMA(1, 1, At, B1); PG8_BAR; PG8_SCHED;
            } else {
            PG8_LDB8(B08, 0, 0); PG8_LDB8(B18, 0, 1); PG8_SCHED; PG8_LDA8(At8, 0, 0); PG8_STAGE(PG8_SA(1, 1), a1, vc[1]);
            PG8_WAIT_V(8); PG8_WAIT_L(0); PG8_BAR; PG8_SCHED; PG8_MMA8(0, 0, At8, B08); PG8_MMA8(0, 1, At8, B18); PG8_SCHED; PG8_BAR; PG8_SCHED;
            PG8_LDA8(At8, 0, 1); PG8_STAGE(PG8_SB(0, 0), b2, voffB); PG8_STAGE(PG8_SB(0, 1), b2 + hstepB, voffB); PG8_STAGE(PG8_SA(0, 0), a2, w0);
            PG8_WAIT_V(8); PG8_WAIT_L(0); PG8_BAR; PG8_SCHED; PG8_MMA8(1, 0, At8, B08); PG8_MMA8(1, 1, At8, B18); PG8_SCHED; PG8_BAR; PG8_SCHED;
            PG8_LDB8(B08, 1, 0); PG8_LDB8(B18, 1, 1); PG8_SCHED; PG8_LDA8(At8, 1, 0); PG8_STAGE(PG8_SA(0, 1), a2, w1);
            PG8_WAIT_V(8); PG8_WAIT_L(0); PG8_BAR; PG8_SCHED; PG8_MMA8(0, 0, At8, B08); PG8_MMA8(0, 1, At8, B18); PG8_SCHED; PG8_BAR; PG8_SCHED;
            PG8_LDA8(At8, 1, 1); PG8_STAGE(PG8_SB(1, 0), b3, voffB); PG8_STAGE(PG8_SB(1, 1), b3 + hstepB, voffB); PG8_STAGE(PG8_SA(1, 0), a3, w0);
            PG8_WAIT_V(8); PG8_WAIT_L(0); PG8_BAR; PG8_SCHED; PG8_MMA8(1, 0, At8, B08); PG8_MMA8(1, 1, At8, B18); PG8_SCHED; PG8_BAR; PG8_SCHED;
            }
        }
        if (wr == 0) PG8_BAR;
        E(acc, cur, wr, wc, fr, fq);
        if (!has_next) break;
#pragma unroll
        for (int a = 0; a < 2; ++a)
#pragma unroll
            for (int b = 0; b < 2; ++b)
#pragma unroll
                for (int m = 0; m < 4; ++m)
#pragma unroll
                    for (int n = 0; n < 2; ++n) acc[a][b][m][n] = (f32x4){0.f, 0.f, 0.f, 0.f};
        cur = nxt; cB = nB; ++ui;
#pragma unroll
        for (int h = 0; h < 2; ++h)
#pragma unroll
            for (int i = 0; i < 2; ++i) vc[h][i] = vn[h][i];
        if (wr == 1) PG8_BAR;
    }
    PG8_WAIT_V(0);
    PG8_BAR;
#undef PG8_SA
#undef PG8_SB
#undef PG8_STAGE
#undef PG8_LDA
#undef PG8_LDB
#undef PG8_MMA
#undef PG8_LDA8
#undef PG8_LDB8
#undef PG8_MMA8
#undef PG8_WAIT_V
#undef PG8_WAIT_L
#undef PG8_BAR
#undef PG8_SCHED
}
}

namespace att {
#define ATT_LAS __attribute__((address_space(3)))
typedef unsigned short bf16_t;
typedef short bf16x8 __attribute__((ext_vector_type(8)));
typedef short s16x4 __attribute__((ext_vector_type(4)));
typedef float f32x16 __attribute__((ext_vector_type(16)));
typedef unsigned u32x4 __attribute__((ext_vector_type(4)));
constexpr int PITCH = 64, OPITCH = D, NSLOT = 3, GRPB = NSLOT * 16384;
constexpr size_t KIND = (size_t)BATCH * 8 * SEQ * 64;
constexpr int LDS_RING = 0, LDS_WS = GRPB, LDS_TB = LDS_WS + 2048, TBS = 324, TB0 = 192, LDS_FLAG = LDS_TB + 8 * TBS * 4, LDS_GBAR = LDS_FLAG + 64, LDS_OST = LDS_GBAR + 64, LDS_END = LDS_OST + 4 * 4096;
constexpr float SB_EXIT = 1.17549435e-38f;
constexpr float CA_THR = 6.0f;
__device__ __forceinline__ int crow(int r, int hi) { return (r & 3) + 8 * (r >> 2) + 4 * hi; }
__device__ __forceinline__ unsigned cvtpk(float lo, float hi) { return pg8::cvt_pk_bf16(lo, hi); }
__device__ __forceinline__ s16x4 vtr(const ATT_LAS char* p) { typedef short v4i16_t __attribute__((ext_vector_type(4))); return __builtin_bit_cast(s16x4, __builtin_amdgcn_ds_read_tr16_b64_v4i16((ATT_LAS v4i16_t*)p)); }
__device__ __forceinline__ float xsum32(float v) { auto rr = __builtin_amdgcn_permlane32_swap(__float_as_uint(v), __float_as_uint(v), false, false); return __uint_as_float(rr[0]) + __uint_as_float(rr[1]); }
__device__ __forceinline__ float xmax32(float v) { auto rr = __builtin_amdgcn_permlane32_swap(__float_as_uint(v), __float_as_uint(v), false, false); return fmaxf(__uint_as_float(rr[0]), __uint_as_float(rr[1])); }
struct GBar { ATT_LAS unsigned* cnt; unsigned target; };
__device__ __forceinline__ void gbar_arrive_wait(GBar& b, int lane) {
    if (lane == 0) __hip_atomic_fetch_add(b.cnt, 1u, __ATOMIC_RELAXED, __HIP_MEMORY_SCOPE_WORKGROUP);
    b.target += 4u;
    for (;;) { const unsigned v = __hip_atomic_load(b.cnt, __ATOMIC_RELAXED, __HIP_MEMORY_SCOPE_WORKGROUP); if ((int)((unsigned)__builtin_amdgcn_readfirstlane(v) - b.target) >= 0) break; }
    asm volatile("" ::: "memory");
}
#define ATT_BAR() do { asm volatile("s_waitcnt vmcnt(0) lgkmcnt(0)" ::: "memory"); gbar_arrive_wait(gb, lane); } while (0)
#define ATT_BAR4() do { asm volatile("s_waitcnt vmcnt(4) lgkmcnt(0)" ::: "memory"); gbar_arrive_wait(gb, lane); } while (0)

__device__ __forceinline__ void dma_tile(ATT_LAS char* dst, const bf16_t* Kb, const bf16_t* Vb, int k0, int g, int lane) {
#pragma unroll
    for (int j = 0; j < 2; ++j) { const int i = 2 * g + j; const int row = 8 * i + (lane >> 3); const int ch = (lane & 7) ^ ((row >> 1) & 7);
        __builtin_amdgcn_global_load_lds((const unsigned*)(Kb + (size_t)(k0 + row) * PITCH + ch * 8), (ATT_LAS unsigned*)(dst + i * 1024), 16, 0, 0); }
#pragma unroll
    for (int j = 0; j < 2; ++j) { const int i = 2 * g + j;
        __builtin_amdgcn_global_load_lds((const unsigned*)(Vb + (size_t)(k0 + 16 * (i & 3) + (lane >> 2)) * PITCH + (i >> 2) * 32 + (lane & 3) * 8), (ATT_LAS unsigned*)(dst + 8192 + i * 1024), 16, 0, 0); }
}
__device__ __forceinline__ void qkt(f32x16& p0, f32x16& p1, const ATT_LAS char* kb, int lane, const bf16x8 (&qr)[4]) {
    const int r32 = lane & 31, hi = lane >> 5, xr = (r32 >> 1) & 7;
    const f32x16 z = {0.f, 0.f, 0.f, 0.f, 0.f, 0.f, 0.f, 0.f, 0.f, 0.f, 0.f, 0.f, 0.f, 0.f, 0.f, 0.f};
    bf16x8 kf[8];
#pragma unroll
    for (int d0 = 0; d0 < 4; ++d0) { const ATT_LAS char* p = kb + r32 * 128 + (((2 * d0 + hi) ^ xr) * 16); kf[2 * d0] = *(const ATT_LAS bf16x8*)p; kf[2 * d0 + 1] = *(const ATT_LAS bf16x8*)(p + 4096); }
    p0 = __builtin_amdgcn_mfma_f32_32x32x16_bf16(kf[0], qr[0], z, 0, 0, 0); p1 = __builtin_amdgcn_mfma_f32_32x32x16_bf16(kf[1], qr[0], z, 0, 0, 0);
#pragma unroll
    for (int d0 = 1; d0 < 4; ++d0) { p0 = __builtin_amdgcn_mfma_f32_32x32x16_bf16(kf[2 * d0], qr[d0], p0, 0, 0, 0); p1 = __builtin_amdgcn_mfma_f32_32x32x16_bf16(kf[2 * d0 + 1], qr[d0], p1, 0, 0, 0); }
}
__device__ __forceinline__ void pv(f32x16 (&o)[2], const ATT_LAS char* vp, const f32x16& p0, const f32x16& p1) {
    bf16x8 pa[4];
#pragma unroll
    for (int ks = 0; ks < 4; ++ks) { u32x4 w;
#pragma unroll
        for (int j = 0; j < 4; ++j) { const int r = (ks & 1) * 8 + 2 * j; w[j] = (ks < 2) ? cvtpk(p0[r], p0[r + 1]) : cvtpk(p1[r], p1[r + 1]); }
        pa[ks] = __builtin_bit_cast(bf16x8, w); }
#pragma unroll
    for (int d0 = 0; d0 < 2; ++d0)
#pragma unroll
        for (int ks = 0; ks < 4; ++ks) { const s16x4 lo = vtr(vp + d0 * 4096 + ks * 1024), hh = vtr(vp + d0 * 4096 + ks * 1024 + 512);
            const bf16x8 vf = {lo[0], lo[1], lo[2], lo[3], hh[0], hh[1], hh[2], hh[3]};
            o[d0] = __builtin_amdgcn_mfma_f32_32x32x16_bf16(pa[ks], vf, o[d0], 0, 0, 0); }
}
struct OPend { bf16_t* dst; };
__device__ __forceinline__ void stage_o(ATT_LAS bf16_t* stg, const f32x16 (&o)[2], int lane) {
    const int r32 = lane & 31, hi = lane >> 5;
#pragma unroll
    for (int r = 0; r < 16; ++r)
#pragma unroll
        for (int d0 = 0; d0 < 2; ++d0) { const unsigned w = cvtpk(o[d0][r], 0.f); stg[crow(r, hi) * 64 + d0 * 32 + r32] = (bf16_t)(w & 0xffffu); }
}
__device__ __forceinline__ void flush_o(const ATT_LAS bf16_t* stg, OPend& p, int lane) {
    if (p.dst == nullptr) return;
#pragma unroll
    for (int i = 0; i < 4; ++i) { const int row = i * 8 + (lane >> 3), ch = lane & 7; const u32x4 v = *(const ATT_LAS u32x4*)(stg + row * 64 + ch * 8); *(u32x4*)(p.dst + (size_t)row * OPITCH + ch * 8) = v; }
    p.dst = nullptr;
}

__device__ __forceinline__ void sb_tile(f32x16& p0, f32x16& p1, float& carry, bool diag, int lim, int hi) {
    if (diag) {
#pragma unroll
        for (int r = 0; r < 16; ++r) { const int kv = crow(r, hi); if (kv >= lim) p0[r] = -1e30f; if (kv + 32 >= lim) p1[r] = -1e30f; } }
    f32x16 r0, r1;
#pragma unroll
    for (int r = 0; r < 16; ++r) { const float v0 = __builtin_amdgcn_exp2f(fminf(p0[r], 100.f)), v1 = __builtin_amdgcn_exp2f(fminf(p1[r], 100.f));
        r0[r] = __builtin_amdgcn_rcpf(1.0f + v0); r1[r] = __builtin_amdgcn_rcpf(1.0f + v1); p0[r] = v0 * r0[r]; p1[r] = v1 * r1[r]; }
    float ex[8]; float T = carry;
    { float qs[8], E[8], Od[8];
#pragma unroll
        for (int g = 0; g < 4; ++g) { qs[g] = (r0[4 * g] * r0[4 * g + 1]) * (r0[4 * g + 2] * r0[4 * g + 3]); qs[4 + g] = (r1[4 * g] * r1[4 * g + 1]) * (r1[4 * g + 2] * r1[4 * g + 3]); }
#pragma unroll
        for (int g = 0; g < 8; ++g) { auto rr = __builtin_amdgcn_permlane32_swap(__float_as_uint(qs[g]), __float_as_uint(qs[g]), false, false); E[g] = __uint_as_float(rr[0]); Od[g] = __uint_as_float(rr[1]); }
#pragma unroll
        for (int g = 7; g >= 0; --g) { const float exO = T; T *= Od[g]; const float exE = T; T *= E[g]; ex[g] = hi ? exO : exE; } }
    carry = T;
#pragma unroll
    for (int g = 0; g < 4; ++g) {
        float f = ex[g];
#pragma unroll
        for (int i = 3; i >= 0; --i) { p0[4 * g + i] *= f; f *= r0[4 * g + i]; }
        f = ex[4 + g];
#pragma unroll
        for (int i = 3; i >= 0; --i) { p1[4 * g + i] *= f; f *= r1[4 * g + i]; }
    }
}

__device__ __forceinline__ void sb_stream(const bf16_t* QKVG, bf16_t* O, ATT_LAS char* lds, int wave, int lane, GBar& gb, OPend& op, int vcu, int G) {
    const int g = wave & 3, r32 = lane & 31, hi = lane >> 5;
    const int nu = (vcu < BATCH * 8 * 32) ? (BATCH * 8 * 32 - vcu + G - 1) / G : 0;
    if (nu == 0) return;
    ATT_LAS char* ring = lds + LDS_RING;
    ATT_LAS unsigned* flag = (ATT_LAS unsigned*)(lds + LDS_FLAG);
    ATT_LAS bf16_t* stg = (ATT_LAS bf16_t*)(lds + LDS_OST + wave * 4096);
    const int vpo = 8192 + ((lane >> 4) & 1) * 32 + (lane & 3) * 8 + (4 * hi + ((lane & 15) >> 2)) * 64;
    int b, h, cp, cw, q0, kt_hi; const bf16_t* Kb; const bf16_t* Vb; bf16x8 qr[4];
#define SB_SETUP(ui) do { const int u_ = vcu + G * (ui), bh_ = u_ >> 5; cp = u_ & 31; b = bh_ >> 3; h = bh_ & 7; cw = 2 * cp + (g >> 1); q0 = cw * 64 + (g & 1) * 32; kt_hi = 2 * cp + 1; \
        const size_t hb_ = (size_t)bh_ * SEQ * 64; Kb = QKVG + 1 * KIND + hb_; Vb = QKVG + 2 * KIND + hb_; const bf16_t* q_ = QKVG + 0 * KIND + hb_ + (size_t)(q0 + r32) * 64; \
        _Pragma("unroll") for (int d0 = 0; d0 < 4; ++d0) qr[d0] = *(const bf16x8*)(q_ + d0 * 16 + hi * 8); asm volatile("" ::: "memory"); \
        dma_tile(ring, Kb, Vb, kt_hi * 64, g, lane); dma_tile(ring + 16384, Kb, Vb, (kt_hi - 1) * 64, g, lane); } while (0)
    ATT_BAR();
    flush_o(stg, op, lane); asm volatile("" ::: "memory");
    SB_SETUP(0);
    for (int ui = 0; ui < nu; ++ui) {
        f32x16 o[2]; o[0] = (f32x16){0.f, 0.f, 0.f, 0.f, 0.f, 0.f, 0.f, 0.f, 0.f, 0.f, 0.f, 0.f, 0.f, 0.f, 0.f, 0.f}; o[1] = o[0];
        float carry = 1.0f; bool done = false, ahead = true; int sl = 0;
        for (int it = 0;; ++it) {
            const int kt = kt_hi - it;
            if (ahead) ATT_BAR4(); else ATT_BAR();
            if (it > 0) { const ATT_LAS unsigned* f = flag + ((it - 1) & 1) * 4; const unsigned a = f[0] & f[1] & f[2] & f[3];
                if (__builtin_amdgcn_readfirstlane(a)) break; }
            flush_o(stg, op, lane); asm volatile("" ::: "memory");
            const int sl2 = (sl >= 1) ? sl - 1 : 2;
            const bool issue = ahead && (kt >= 2);
            if (issue) dma_tile(ring + sl2 * 16384, Kb, Vb, (kt - 2) * 64, g, lane);
            if (!done && kt <= cw) {
                const ATT_LAS char* slot = ring + sl * 16384;
                f32x16 p0, p1; qkt(p0, p1, slot, lane, qr);
                sb_tile(p0, p1, carry, kt == cw, q0 - kt * 64 + r32, hi);
                pv(o, slot + vpo, p0, p1);
                done = (kt == 0) || __all(carry < SB_EXIT);
            }
            if (lane == 0) flag[(it & 1) * 4 + g] = done ? 1u : 0u;
            ahead = issue; sl = (sl == 2) ? 0 : sl + 1;
        }
        bf16_t* odst = O + ((size_t)b * SEQ + q0) * OPITCH + h * 64;
        if (ui + 1 < nu) SB_SETUP(ui + 1);
        stage_o(stg, o, lane); op.dst = odst;
    }
    asm volatile("s_waitcnt vmcnt(0)" ::: "memory");
#undef SB_SETUP
}

__device__ __forceinline__ void ca_stream(const bf16_t* QKVG, bf16_t* O, ATT_LAS char* lds, int wave, int lane, GBar& gb, OPend& op, int vcu, int G) {
    const int g = wave & 3, r32 = lane & 31, hi = lane >> 5;
    const int nu = (vcu < BATCH * 8 * 32) ? (BATCH * 8 * 32 - vcu + G - 1) / G : 0;
    if (nu == 0) return;
    ATT_LAS char* ring = lds + LDS_RING;
    ATT_LAS float* wsf = (ATT_LAS float*)(lds + LDS_WS + wave * 256);
    ATT_LAS bf16_t* stg = (ATT_LAS bf16_t*)(lds + LDS_OST + wave * 4096);
    const int vpo = 8192 + ((lane >> 4) & 1) * 32 + (lane & 3) * 8 + (4 * hi + ((lane & 15) >> 2)) * 64;
    int d_ui = 0, d_kc, d_hi, d_sl = 0, issued = 0; const bf16_t* d_K; const bf16_t* d_V; bool d_valid = true;
#define CA_SETUP_D(ui) do { const int u_ = vcu + G * (ui), bh_ = u_ >> 5, cp_ = u_ & 31; const size_t hb_ = (size_t)bh_ * SEQ * 64; d_K = QKVG + 4 * KIND + hb_; d_V = QKVG + 5 * KIND + hb_; d_kc = (2 * cp_ >= 8) ? 2 * cp_ - 8 : 0; d_hi = 2 * cp_ + 1; } while (0)
#define CA_LOADQ(dst, ui) do { const int u_ = vcu + G * (ui), bh_ = u_ >> 5, cp_ = u_ & 31; const bf16_t* q_ = QKVG + 3 * KIND + (size_t)bh_ * SEQ * 64 + (size_t)((2 * cp_ + (g >> 1)) * 64 + (g & 1) * 32 + r32) * 64; \
        _Pragma("unroll") for (int d0 = 0; d0 < 4; ++d0) dst[d0] = *(const bf16x8*)(q_ + d0 * 16 + hi * 8); } while (0)
#define CA_ISSUE() do { if (d_valid) { \
        dma_tile(ring + d_sl * 16384, d_K, d_V, d_kc * 64, g, lane); ++issued; d_sl = (d_sl == 2) ? 0 : d_sl + 1; \
        if (d_kc == d_hi) { ++d_ui; if (d_ui < nu) CA_SETUP_D(d_ui); else d_valid = false; } else ++d_kc; } } while (0)
    bf16x8 qr[4], qn[4];
    CA_SETUP_D(0);
    CA_LOADQ(qr, 0);
#pragma unroll
    for (int d0 = 0; d0 < 4; ++d0) qn[d0] = qr[d0];
    ATT_BAR();
    flush_o(stg, op, lane); asm volatile("" ::: "memory");
    CA_ISSUE(); CA_ISSUE();
    int c_ui = 0, T = 0, slc = 0;
    int cp, b, h, cw, q0, kc, kc_hi; const ATT_LAS float* tbh; float bfar;
#define CA_SETUP_C(ui) do { const int u_ = vcu + G * (ui), bh_ = u_ >> 5; cp = u_ & 31; b = bh_ >> 3; h = bh_ & 7; cw = 2 * cp + (g >> 1); q0 = cw * 64 + (g & 1) * 32; kc = (2 * cp >= 8) ? 2 * cp - 8 : 0; kc_hi = 2 * cp + 1; \
        tbh = (const ATT_LAS float*)(lds + LDS_TB) + h * TBS; bfar = tbh[512 - TB0]; } while (0)
    CA_SETUP_C(0);
    f32x16 o[2]; o[0] = (f32x16){0.f, 0.f, 0.f, 0.f, 0.f, 0.f, 0.f, 0.f, 0.f, 0.f, 0.f, 0.f, 0.f, 0.f, 0.f, 0.f}; o[1] = o[0];
    float m_run = -1e30f, l = 0.f;
    for (;;) {
        if (issued > T + 1) ATT_BAR4(); else ATT_BAR();
        flush_o(stg, op, lane);
        if (kc == kc_hi - 1 && c_ui + 1 < nu) CA_LOADQ(qn, c_ui + 1);
        asm volatile("" ::: "memory");
        CA_ISSUE();
        if (kc + 8 >= cw && kc <= cw) {
            const ATT_LAS char* slot = ring + slc * 16384;
            f32x16 p0, p1; qkt(p0, p1, slot, lane, qr);
            const int dl = q0 + r32 - kc * 64 - 4 * hi;
            if (cw - kc >= 5) {
#pragma unroll
                for (int r = 0; r < 16; ++r) { p0[r] += bfar; p1[r] += bfar; }
            } else {
#pragma unroll
                for (int r = 0; r < 16; ++r) { const int cr = (r & 3) + 8 * (r >> 2); int i0 = dl - cr, i1 = dl - cr - 32; i0 = (i0 > 256 ? 256 : i0) + (256 - TB0); i1 = (i1 > 256 ? 256 : i1) + (256 - TB0);
                    p0[r] += tbh[i0]; p1[r] += tbh[i1]; }
            }
            float mt = fmaxf(p0[0], p1[0]);
#pragma unroll
            for (int r = 1; r < 16; ++r) mt = fmaxf(mt, fmaxf(p0[r], p1[r]));
            mt = xmax32(mt);
            if (__any(mt > m_run + CA_THR)) {
                const float m_new = (mt > m_run + CA_THR) ? mt : m_run; const float alpha = __builtin_amdgcn_exp2f(m_run - m_new); m_run = m_new; l *= alpha;
                if (hi == 0) wsf[r32] = alpha;
                asm volatile("" ::: "memory");
#pragma unroll
                for (int r = 0; r < 16; ++r) { const float a = wsf[crow(r, hi)]; o[0][r] *= a; o[1][r] *= a; }
                asm volatile("" ::: "memory");
            }
            float ls = 0.f;
#pragma unroll
            for (int r = 0; r < 16; ++r) { p0[r] = __builtin_amdgcn_exp2f(p0[r] - m_run); p1[r] = __builtin_amdgcn_exp2f(p1[r] - m_run); ls += p0[r] + p1[r]; }
            l += ls;
            pv(o, slot + vpo, p0, p1);
        }
        ++T; slc = (slc == 2) ? 0 : slc + 1;
        if (kc == kc_hi) {
            l = xsum32(l);
            if (hi == 0) wsf[r32] = __builtin_amdgcn_rcpf(l);
            asm volatile("" ::: "memory");
#pragma unroll
            for (int r = 0; r < 16; ++r) { const float a = wsf[crow(r, hi)]; o[0][r] *= a; o[1][r] *= a; }
            asm volatile("" ::: "memory");
            stage_o(stg, o, lane); op.dst = O + ((size_t)b * SEQ + q0) * OPITCH + 512 + h * 64;
            ++c_ui; if (c_ui == nu) break;
            CA_SETUP_C(c_ui);
#pragma unroll
            for (int d0 = 0; d0 < 4; ++d0) qr[d0] = qn[d0];
            o[0] = (f32x16){0.f, 0.f, 0.f, 0.f, 0.f, 0.f, 0.f, 0.f, 0.f, 0.f, 0.f, 0.f, 0.f, 0.f, 0.f, 0.f}; o[1] = o[0]; m_run = -1e30f; l = 0.f;
        } else ++kc;
    }
    asm volatile("s_waitcnt vmcnt(0)" ::: "memory");
#undef CA_SETUP_D
#undef CA_LOADQ
#undef CA_ISSUE
#undef CA_SETUP_C
}
}

constexpr int NWAVES = 8;
constexpr int N_PHASES = 10;
constexpr int N_LAUNCHES = MK_N_LAUNCHES;
static_assert(N_LAUNCHES == 1 || N_LAUNCHES == N_PHASES, "MK_N_LAUNCHES is 1 or 10");
static_assert(att::LDS_END <= 79872 && 79872 + 4 * 16640 <= 146432, "attention + conversion LDS regions");

constexpr size_t MiB = 1u << 20;
constexpr size_t WS_CTL = 0, CTL_ZERO_BYTES = 64 * 1024;
constexpr size_t WS_MOD = 1 * MiB;
constexpr size_t WS_WCAT = 2 * MiB;
constexpr size_t WS_WBR = 12 * MiB;
constexpr size_t WS_WOUT = 14 * MiB;
constexpr size_t WS_W1T = 16 * MiB;
constexpr size_t WS_W2T = 144 * MiB;
constexpr size_t WS_H = 208 * MiB;
constexpr size_t WS_QKVG = 240 * MiB;
constexpr size_t WS_O = 400 * MiB;
constexpr size_t WS_TMP = 432 * MiB;
constexpr size_t WS_MIXIN = 496 * MiB;
constexpr size_t WS_MIXED = 528 * MiB;
constexpr size_t WS_H2 = 560 * MiB;
constexpr size_t WS_HID = 592 * MiB;
constexpr size_t WS_Y = 736 * MiB;
constexpr size_t WS_ROWTOK = 880 * MiB;
constexpr size_t WS_SLOT = 882 * MiB;
constexpr size_t WS_END = 884 * MiB;
constexpr int CW_CNT = 1024;
constexpr int CW_BAR = 4096;

constexpr int RING_BYTES = 131072;
constexpr int LDSCTL_OFF = 146432;
constexpr int LDS_BYTES = 147456;
constexpr int MOETAB_OFF = LDSCTL_OFF + 64;

#define GAS __attribute__((address_space(1)))
#define LAS __attribute__((address_space(3)))
typedef unsigned short bf16;
typedef unsigned v4u __attribute__((ext_vector_type(4)));
typedef unsigned v2u __attribute__((ext_vector_type(2)));
typedef float f32x4 __attribute__((ext_vector_type(4)));
typedef GAS unsigned gu32;
#define RLX_AGENT __ATOMIC_RELAXED, __HIP_MEMORY_SCOPE_AGENT
#define LDS_WAIT() asm volatile("s_waitcnt lgkmcnt(0)" ::: "memory")
#define VM_WAIT() asm volatile("s_waitcnt vmcnt(0)" ::: "memory")

#define XB_TMO      128
#define XB_XCNT(j)  (256  + 64 * (j))
#define XB_XSUB(j)  (1280 + 64 * (j))
#define XB_XGEN(j)  (2304 + 64 * (j))
#define XB_TOP      3328
#define XB_TOPGEN   3392
#define XCD_BAR_WORDS 3456
#define XB_SPIN_CAP (1u << 18)
__device__ __forceinline__ unsigned xb_ld(unsigned* p)              { return __hip_atomic_load(p, __ATOMIC_RELAXED, __HIP_MEMORY_SCOPE_AGENT); }
__device__ __forceinline__ unsigned xb_add(unsigned* p, unsigned v) { return __hip_atomic_fetch_add(p, v, __ATOMIC_RELAXED, __HIP_MEMORY_SCOPE_AGENT); }
__device__ __forceinline__ unsigned xb_xcc_id() { return (unsigned)__builtin_amdgcn_s_getreg((3 << 11) | 20) & 0xFu; }
#define XB_SPIN(cond, bar) do { unsigned _sp = 0; while (cond) { __builtin_amdgcn_s_sleep(1); \
    if ((++_sp & 255u) == 0u) { if (xb_ld(&(bar)[XB_TMO])) break; if (_sp > XB_SPIN_CAP) { atomicAdd(&(bar)[XB_TMO], 1u); break; } } } } while (0)
struct XcdBarrier { unsigned* bar; unsigned x; volatile LAS unsigned* st; };
__device__ __forceinline__ XcdBarrier xcd_barrier_post(unsigned* bar, volatile LAS unsigned* st) {
    XcdBarrier b; b.bar = bar; b.x = xb_xcc_id(); b.st = st;
    if (threadIdx.x == 0) (void)xb_add(&bar[XB_XCNT(b.x)], 1u);
    return b;
}
__device__ __forceinline__ void xcd_barrier_complete(unsigned* bar, unsigned x, unsigned& nloc, unsigned& nx) {
    const unsigned G = gridDim.x * gridDim.y * gridDim.z;
    unsigned sum, cnt, mine, sp = 0u;
    for (;;) {
        sum = 0u; cnt = 0u; mine = 0u;
#pragma unroll
        for (unsigned j = 0; j < 16; ++j) { const unsigned c = xb_ld(&bar[XB_XCNT(j)]); sum += c; cnt += (c > 0u) ? 1u : 0u; mine = (j == x) ? c : mine; }
        if (sum == G) break;
        __builtin_amdgcn_s_sleep(1);
        if ((++sp & 255u) == 0u) { if (xb_ld(&bar[XB_TMO])) break; if (sp > XB_SPIN_CAP) { atomicAdd(&bar[XB_TMO], 1u); break; } }
    }
    nloc = mine > 0u ? mine : 1u; nx = cnt > 0u ? cnt : 1u;
}
__device__ __forceinline__ void xcd_barrier(const XcdBarrier& b) {
    asm volatile("s_waitcnt vmcnt(0)" ::: "memory");
    __syncthreads();
    if (threadIdx.x == 0) {
        unsigned* bar = b.bar;
        __builtin_amdgcn_s_waitcnt(0);
        unsigned nloc = b.st[0], nx = b.st[1];
        if (nloc == 0u) { xcd_barrier_complete(bar, b.x, nloc, nx); b.st[0] = nloc; b.st[1] = nx; }
        const unsigned old = xb_add(&bar[XB_XSUB(b.x)], 1u);
        const unsigned gen = old / nloc;
        if (old + 1u == (gen + 1u) * nloc) {
            __builtin_amdgcn_fence(__ATOMIC_RELEASE, "agent");
            asm volatile("s_waitcnt vmcnt(0)" ::: "memory");
            const unsigned og = xb_add(&bar[XB_TOP], 1u);
            const unsigned tg = og / nx;
            if (og + 1u == (tg + 1u) * nx) xb_add(&bar[XB_TOPGEN], 1u);
            else XB_SPIN(xb_ld(&bar[XB_TOPGEN]) == tg, bar);
            __builtin_amdgcn_fence(__ATOMIC_ACQUIRE, "agent");
            xb_add(&bar[XB_XGEN(b.x)], 1u);
            asm volatile("s_waitcnt vmcnt(0)" ::: "memory");
        } else {
            XB_SPIN(xb_ld(&bar[XB_XGEN(b.x)]) == gen, bar);
            __builtin_amdgcn_fence(__ATOMIC_ACQUIRE, "agent");
            asm volatile("s_waitcnt vmcnt(0)" ::: "memory");
        }
    }
    __syncthreads();
}

__device__ __forceinline__ float wave_sum(float v) {
#pragma unroll
    for (int o = 1; o < 64; o <<= 1) v += __shfl_xor(v, o);
    return v;
}
__device__ __forceinline__ unsigned pk2(float lo, float hi) { return pg8::cvt_pk_bf16(lo, hi); }
template <int CTL> __device__ __forceinline__ float dppf(float v) { return __int_as_float(__builtin_amdgcn_mov_dpp(__float_as_int(v), CTL, 0xF, 0xF, true)); }
__device__ __forceinline__ float sum16x(float v) { auto r = __builtin_amdgcn_permlane16_swap(__float_as_uint(v), __float_as_uint(v), false, false); return __uint_as_float(r[0]) + __uint_as_float(r[1]); }
__device__ __forceinline__ float sum32x(float v) { auto r = __builtin_amdgcn_permlane32_swap(__float_as_uint(v), __float_as_uint(v), false, false); return __uint_as_float(r[0]) + __uint_as_float(r[1]); }
__device__ __forceinline__ float wave_sum_fast(float v) {
    v += dppf<0xB1>(v); v += dppf<0x4E>(v); v += dppf<0x141>(v); v += dppf<0x140>(v); v = sum16x(v); return sum32x(v);
}

struct Args { const float* in[21]; float* out; unsigned char* ws; int ph_lo, ph_hi, li, pad; };

__device__ __forceinline__ void cvt_block(const float* W, int N, int k0, int n0, bf16* WT, int ldk, int drow0, int kd0, LAS float* scr, int lane) {
    const int c4 = 4 * (lane & 15), rq = lane >> 4;
    f32x4 v[16];
#pragma unroll
    for (int i = 0; i < 16; ++i) v[i] = __builtin_nontemporal_load((const GAS f32x4*)(W + (size_t)(k0 + rq + 4 * i) * N + n0 + c4));
#pragma unroll
    for (int i = 0; i < 16; ++i) { LAS float* s = scr + (rq + 4 * i) * 65 + c4; s[0] = v[i].x; s[1] = v[i].y; s[2] = v[i].z; s[3] = v[i].w; }
    LDS_WAIT(); asm volatile("" ::: "memory");
    const int c8 = lane & 7;
#pragma unroll
    for (int j = 0; j < 8; ++j) { const int n = (lane >> 3) + 8 * j; const LAS float* s = scr + (8 * c8) * 65 + n;
        v4u o; o.x = pk2(s[0 * 65], s[1 * 65]); o.y = pk2(s[2 * 65], s[3 * 65]); o.z = pk2(s[4 * 65], s[5 * 65]); o.w = pk2(s[6 * 65], s[7 * 65]);
        *(GAS v4u*)(WT + (size_t)(drow0 + n) * ldk + kd0 + k0 + 8 * c8) = o; }
    LDS_WAIT(); asm volatile("" ::: "memory");
}

__device__ __forceinline__ void cvt_block8(const float* W, int N, int k0, int n0, unsigned char* WT, int ldk, int drow0, LAS float* scr, int lane) {
    const int c4 = 4 * (lane & 15), rq = lane >> 4;
    f32x4 v[16];
#pragma unroll
    for (int i = 0; i < 16; ++i) v[i] = __builtin_nontemporal_load((const GAS f32x4*)(W + (size_t)(k0 + rq + 4 * i) * N + n0 + c4));
#pragma unroll
    for (int i = 0; i < 16; ++i) { LAS float* s = scr + (rq + 4 * i) * 65 + c4; s[0] = v[i].x * pg8::W8_SCALE; s[1] = v[i].y * pg8::W8_SCALE; s[2] = v[i].z * pg8::W8_SCALE; s[3] = v[i].w * pg8::W8_SCALE; }
    LDS_WAIT(); asm volatile("" ::: "memory");
    const int c8 = lane & 7;
#pragma unroll
    for (int j = 0; j < 8; ++j) { const int n = (lane >> 3) + 8 * j; const LAS float* s = scr + (8 * c8) * 65 + n;
        v2u o; o.x = pg8::cvt4_fp8(s[0 * 65], s[1 * 65], s[2 * 65], s[3 * 65]); o.y = pg8::cvt4_fp8(s[4 * 65], s[5 * 65], s[6 * 65], s[7 * 65]);
        __builtin_nontemporal_store(o, (GAS v2u*)(WT + (size_t)(drow0 + n) * ldk + k0 + 8 * c8)); }
    LDS_WAIT(); asm volatile("" ::: "memory");
}

__global__ void __launch_bounds__(NWAVES * 64, 2) mk_fwd(Args args) {
    extern __shared__ __attribute__((aligned(16))) unsigned char lds[];
    LAS unsigned char* L = (LAS unsigned char*)lds;
    const int tid0 = threadIdx.x, wave = __builtin_amdgcn_readfirstlane(tid0 >> 6);
    const int G = gridDim.x, bx = blockIdx.x;
    const int vcu = (G % 8 == 0) ? (bx % 8) * (G / 8) + bx / 8 : bx;
#define PHASE_PTRS() \
    int tid = tid0; asm volatile("" : "+v"(tid)); const int lane = tid & 63; (void)lane; \
    const __attribute__((address_space(4))) Args* ap_ = (const __attribute__((address_space(4))) Args*)__builtin_amdgcn_kernarg_segment_ptr(); asm volatile("" : "+s"(ap_)); \
    unsigned char* ws = ap_->ws; gu32* ctl = (gu32*)(ws + WS_CTL); \
    const float* x = ap_->in[0]; const float* cvec = ap_->in[1]; const float* w_ada = ap_->in[2]; const float* b_ada = ap_->in[3]; \
    const float* g_pre_mix = ap_->in[4]; const float* g_post_mix = ap_->in[5]; const float* w_in = ap_->in[6]; const float* rel_bias = ap_->in[7]; \
    const float* w_br_sb = ap_->in[8]; const float* w_br_ca = ap_->in[9]; const float* w_gate = ap_->in[10]; const float* b_gate = ap_->in[11]; \
    const float* w_out = ap_->in[12]; const float* g_pre_ffn = ap_->in[13]; const float* g_post_ffn = ap_->in[14]; const float* w_router = ap_->in[15]; \
    const float* b_router = ap_->in[16]; const float* w_e1 = ap_->in[17]; const float* b_e1 = ap_->in[18]; const float* w_e2 = ap_->in[19]; const float* b_e2 = ap_->in[20]; \
    float* out = ap_->out; float* MOD = (float*)(ws + WS_MOD); \
    bf16* WCAT = (bf16*)(ws + WS_WCAT); bf16* WBR = (bf16*)(ws + WS_WBR); bf16* WOUT = (bf16*)(ws + WS_WOUT); bf16* W1T = (bf16*)(ws + WS_W1T); bf16* W2T = (bf16*)(ws + WS_W2T); \
    bf16* Hb = (bf16*)(ws + WS_H); bf16* QKVG = (bf16*)(ws + WS_QKVG); bf16* GATES = (bf16*)(ws + WS_QKVG + 96 * MiB); bf16* Ob = (bf16*)(ws + WS_O); float* TMP = (float*)(ws + WS_TMP); \
    bf16* MIXIN = (bf16*)(ws + WS_MIXIN); bf16* MIXED = (bf16*)(ws + WS_MIXED); bf16* H2 = (bf16*)(ws + WS_H2); bf16* HID = (bf16*)(ws + WS_HID); bf16* Yb = (bf16*)(ws + WS_Y); \
    int* ROWTOK = (int*)(ws + WS_ROWTOK); v2u* SLOT = (v2u*)(ws + WS_SLOT); unsigned* gcnt = (unsigned*)(ctl + CW_CNT); \
    const bool probe = ap_->li != 0; \
    float* x1o = probe ? TMP : out; bf16* h2o = probe ? MIXIN : H2; int* rowtok_o = probe ? (int*)HID : ROWTOK; v2u* slot_o = probe ? (v2u*)(HID + 8 * MiB) : SLOT; unsigned* gcnt_o = probe ? gcnt + 32 : gcnt; \
    (void)x; (void)cvec; (void)w_ada; (void)b_ada; (void)g_pre_mix; (void)g_post_mix; (void)w_in; (void)rel_bias; (void)w_br_sb; (void)w_br_ca; (void)w_gate; (void)b_gate; (void)w_out; (void)g_pre_ffn; (void)g_post_ffn; \
    (void)w_router; (void)b_router; (void)w_e1; (void)b_e1; (void)w_e2; (void)b_e2; (void)out; (void)MOD; (void)WCAT; (void)WBR; (void)WOUT; (void)W1T; (void)W2T; (void)Hb; (void)QKVG; (void)GATES; (void)Ob; (void)TMP; \
    (void)MIXIN; (void)MIXED; (void)H2; (void)HID; (void)Yb; (void)ROWTOK; (void)SLOT; (void)gcnt; (void)x1o; (void)h2o; (void)rowtok_o; (void)slot_o; (void)gcnt_o
    gu32* const ctl0 = (gu32*)(args.ws + WS_CTL);
    for (int u = tid0; u < (LDS_BYTES - LDSCTL_OFF) / 4; u += NWAVES * 64) ((LAS unsigned*)(L + LDSCTL_OFF))[u] = 0u;
    __syncthreads();
    XcdBarrier bar; bar.bar = (unsigned*)(ctl0 + CW_BAR); bar.x = 0; bar.st = nullptr;
    if (N_LAUNCHES == 1) bar = xcd_barrier_post((unsigned*)(ctl0 + CW_BAR), (volatile LAS unsigned*)(L + LDSCTL_OFF));
    const int lo = args.ph_lo, hi_ph = args.ph_hi;
#define IN(k) (lo <= (k) && (k) < hi_ph)
#define SEAM(k) do { if (IN(k) && IN((k) + 1)) xcd_barrier(bar); } while (0)
    const int gw = vcu * NWAVES + wave, NGW = G * NWAVES;

    if (IN(0)) { PHASE_PTRS();
        LAS float* cl = (LAS float*)L;
        LAS float* red = (LAS float*)(L + 16384);
        for (int i = tid; i < BATCH * D; i += NWAVES * 64) cl[i] = cvec[i];
        __syncthreads();
        for (int t = bx; t < 192; t += G) {
            const int col = 32 * t + (lane & 31), sub = 2 * wave + (lane >> 5);
            float a0 = 0.f, a1 = 0.f, a2 = 0.f, a3 = 0.f;
#pragma unroll 16
            for (int kk = 0; kk < 64; ++kk) { const int k = 64 * sub + kk; const float w = w_ada[(size_t)k * 6144 + col];
                a0 += cl[k] * w; a1 += cl[1024 + k] * w; a2 += cl[2048 + k] * w; a3 += cl[3072 + k] * w; }
            red[(sub * 4 + 0) * 32 + (lane & 31)] = a0; red[(sub * 4 + 1) * 32 + (lane & 31)] = a1; red[(sub * 4 + 2) * 32 + (lane & 31)] = a2; red[(sub * 4 + 3) * 32 + (lane & 31)] = a3;
            __syncthreads();
            if (tid < 128) { const int b = tid >> 5, cc = tid & 31; float s = b_ada[32 * t + cc];
#pragma unroll
                for (int q = 0; q < 16; ++q) s += red[(q * 4 + b) * 32 + cc];
                MOD[b * 6144 + 32 * t + cc] = s; }
            __syncthreads();
        }
        __syncthreads();
        LAS float* scr = (LAS float*)(L + wave * 16640);
        constexpr int I0 = 16 * 48, I1 = 16 * 32, I2 = 8 * 16, I3 = 8 * 16, I4 = 16 * 16, I5 = NE * 16 * 32, I6 = NE * 16 * 16;
        constexpr int NITEMS = I0 + I1 + I2 + I3 + I4;
        for (int it = gw; it < NITEMS; it += NGW) {
            int r = it;
            if (r < I0) { const int kb = r / 48, nb = r % 48; cvt_block(w_in, 3072, 64 * kb, 64 * nb, WCAT, 1024, 64 * nb, 0, scr, lane); continue; } r -= I0;
            if (r < I1) { const int kb = r / 32, nb = r % 32; cvt_block(w_gate, 2048, 64 * kb, 64 * nb, WCAT, 1024, 3072 + 64 * nb, 0, scr, lane); continue; } r -= I1;
            if (r < I2) { const int kb = r / 16, nb = r % 16; cvt_block(w_br_sb, 1024, 64 * kb, 64 * nb, WBR, 1024, 64 * nb, 0, scr, lane); continue; } r -= I2;
            if (r < I3) { const int kb = r / 16, nb = r % 16; cvt_block(w_br_ca, 1024, 64 * kb, 64 * nb, WBR, 1024, 64 * nb, 512, scr, lane); continue; } r -= I3;
            { const int kb = r / 16, nb = r % 16; cvt_block(w_out, 1024, 64 * kb, 64 * nb, WOUT, 1024, 64 * nb, 0, scr, lane); }
        }
    }
    SEAM(0);

    if (IN(1)) { PHASE_PTRS();
        for (int b = 0; b < BATCH; ++b) {
            f32x4 ca[4], cb[4];
#pragma unroll
            for (int j = 0; j < 4; ++j) { const int c = 4 * lane + 256 * j; const f32x4 gg = *(const f32x4*)(g_pre_mix + c), sc = *(const f32x4*)(MOD + b * 6144 + 1024 + c); ca[j] = gg * (sc + 1.0f); cb[j] = *(const f32x4*)(MOD + b * 6144 + c); }
            for (int m = b * SEQ + gw; m < (b + 1) * SEQ; m += NGW) {
                const f32x4* xr = (const f32x4*)(x + (size_t)m * D) + lane; f32x4 v[4]; float s = 0.f;
#pragma unroll
                for (int j = 0; j < 4; ++j) { v[j] = __builtin_nontemporal_load(xr + 64 * j); s += (v[j].x * v[j].x + v[j].y * v[j].y) + (v[j].z * v[j].z + v[j].w * v[j].w); }
                const float rstd = 1.0f / sqrtf(wave_sum(s) * (1.0f / D) + RMS_EPS);
                v2u* o8 = (v2u*)(Hb + (size_t)m * D) + lane;
#pragma unroll
                for (int j = 0; j < 4; ++j) { const f32x4 hv = v[j] * rstd * ca[j] + cb[j]; v2u w; w.x = pk2(hv.x, hv.y); w.y = pk2(hv.z, hv.w); o8[64 * j] = w; }
            }
        }
    }
    SEAM(1);

    if (IN(2)) { PHASE_PTRS();
        pg8::Gemm g{Hb, WCAT, D, D, D, 128}; pg8::PlainOrder S{M / 256, NCAT / 256, G, bx, 256};
        pg8::EpiProj E{QKVG, GATES, b_gate};
        pg8::gemm_phase<pg8::EpiProj, pg8::PlainOrder>(L, g, S, E);
    }
    SEAM(2);

    if (IN(3)) { PHASE_PTRS();
        LAS float* tb = (LAS float*)(L + att::LDS_TB);
        for (int i = tid; i < 8 * 321; i += NWAVES * 64) { const int hh = i / 321, j = i % 321; tb[hh * att::TBS + j] = rel_bias[hh * 513 + att::TB0 + j] * LOG2E; }
        if (tid < 32) ((LAS unsigned*)(L + att::LDS_FLAG))[tid] = 0u;
        __syncthreads();
        if (wave < 4) {
            att::GBar gb{(LAS unsigned*)(L + att::LDS_GBAR), 0u};
            att::OPend op{nullptr};
            att::ca_stream(QKVG, Ob, (LAS char*)L, wave, lane, gb, op, vcu, G);
            att::sb_stream(QKVG, Ob, (LAS char*)L, wave, lane, gb, op, vcu, G);
            att::flush_o((const att::bf16_t LAS*)(L + att::LDS_OST + wave * 4096), op, lane);
        } else {
            LAS float* scr = (LAS float*)(L + 79872 + (wave - 4) * 16640);
            constexpr int I5 = NE * 16 * 32, I6 = NE * 16 * 16;
            for (int it = vcu * 4 + (wave - 4); it < I5 + I6; it += G * 4) {
                int r = it;
                if (r < I5) { const int e = r / 512, q = r % 512, kb = q / 32, nb = q % 32; const int n0 = 64 * nb;
                    const int dr = (n0 < 1024) ? (256 * (n0 >> 7) + (n0 & 127)) : (256 * ((n0 - 1024) >> 7) + 128 + ((n0 - 1024) & 127));
                    cvt_block8(w_e1 + (size_t)e * 1024 * 2048, 2048, 64 * kb, n0, (unsigned char*)W1T, 1024, e * 2048 + dr, scr, lane); __builtin_amdgcn_s_sleep(64); continue; } r -= I5;
                { const int e = r / 256, q = r % 256, kb = q / 16, nb = q % 16; cvt_block8(w_e2 + (size_t)e * 1024 * 1024, 1024, 64 * kb, 64 * nb, (unsigned char*)W2T, 1024, e * 1024 + 64 * nb, scr, lane); }
                __builtin_amdgcn_s_sleep(64);
            }
        }
        __syncthreads();
    }
    SEAM(3);

    if (IN(4)) { PHASE_PTRS();
        pg8::Gemm g{Ob, WBR, D, D, D, 0}; pg8::PlainOrder S{M / 256, D / 128, G, bx, 128};
        pg8::EpiMix2 E{GATES, MIXIN};
        pg8::gemm_phase<pg8::EpiMix2, pg8::PlainOrder, 2>(L, g, S, E);
    }
    SEAM(4);

    if (IN(5)) { PHASE_PTRS();
        pg8::Gemm g{MIXIN, WOUT, D, D, D, 128}; pg8::PlainOrder S{M / 256, D / 256, G, bx, 256};
        pg8::EpiStore E{MIXED, D, nullptr, 1, 0, 1.0f, 0};
        pg8::gemm_phase<pg8::EpiStore, pg8::PlainOrder>(L, g, S, E);
    }
    SEAM(5);

    if (IN(6)) { PHASE_PTRS();
        LAS float* wrT = (LAS float*)L;
        LAS float* lgs = (LAS float*)(L + 131584);
        LAS unsigned* lcnt = (LAS unsigned*)(L + 131584 + 8448);
        LAS unsigned* asg = (LAS unsigned*)(L + 131584 + 8448 + 256);
        { f32x4 wv[16];
#pragma unroll
          for (int k = 0; k < 16; ++k) wv[k] = *(const f32x4*)(w_router + 4 * (tid + 512 * k));
#pragma unroll
          for (int k = 0; k < 16; ++k) { const int i4 = tid + 512 * k, c = i4 >> 3, e4 = (i4 & 7) * 4; wrT[(e4 + 0) * 1028 + c] = wv[k].x; wrT[(e4 + 1) * 1028 + c] = wv[k].y; wrT[(e4 + 2) * 1028 + c] = wv[k].z; wrT[(e4 + 3) * 1028 + c] = wv[k].w; } }
        __syncthreads();
        for (int ch = bx; ch < M / 64; ch += G) {
            if (tid < 32) lcnt[tid] = 0u;
            const int b = (ch * 64) / SEQ;
            f32x4 pa[4], pb[4], pc[4];
#pragma unroll
            for (int j = 0; j < 4; ++j) { const int c = 4 * lane + 256 * j;
                pa[j] = *(const f32x4*)(g_post_mix + c) * *(const f32x4*)(MOD + b * 6144 + 2048 + c);
                pb[j] = *(const f32x4*)(g_pre_ffn + c) * (*(const f32x4*)(MOD + b * 6144 + 4096 + c) + 1.0f);
                pc[j] = *(const f32x4*)(MOD + b * 6144 + 3072 + c); }
            for (int rr = 0; rr < 8; rr += 2) {
                const int m = ch * 64 + wave * 8 + rr;
                v2u rm[2][4]; f32x4 rx[2][4];
#pragma unroll
                for (int q = 0; q < 2; ++q)
#pragma unroll
                    for (int j = 0; j < 4; ++j) { rm[q][j] = ((const v2u*)(MIXED + (size_t)(m + q) * D) + lane)[64 * j]; rx[q][j] = __builtin_nontemporal_load((const f32x4*)(x + (size_t)(m + q) * D) + lane + 64 * j); }
                f32x4 xv[2][4];
#pragma unroll
                for (int q = 0; q < 2; ++q) {
                    float s = 0.f, s2 = 0.f; f32x4 mx[4];
#pragma unroll
                    for (int j = 0; j < 4; ++j) { const v2u w = rm[q][j]; mx[j] = (f32x4){pg8::bf_lo(w.x), pg8::bf_hi(w.x), pg8::bf_lo(w.y), pg8::bf_hi(w.y)};
                        s += (mx[j].x * mx[j].x + mx[j].y * mx[j].y) + (mx[j].z * mx[j].z + mx[j].w * mx[j].w); }
                    const float rstd = 1.0f / sqrtf(wave_sum_fast(s) * (1.0f / D) + RMS_EPS);
#pragma unroll
                    for (int j = 0; j < 4; ++j) { xv[q][j] = rx[q][j] + pa[j] * (mx[j] * rstd); s2 += (xv[q][j].x * xv[q][j].x + xv[q][j].y * xv[q][j].y) + (xv[q][j].z * xv[q][j].z + xv[q][j].w * xv[q][j].w); }
                    const float rstd2 = 1.0f / sqrtf(wave_sum_fast(s2) * (1.0f / D) + RMS_EPS);
                    unsigned* h2r = (unsigned*)((unsigned char*)h2o + (size_t)(m + q) * D) + lane;
#pragma unroll
                    for (int j = 0; j < 4; ++j) { xv[q][j] = xv[q][j] * rstd2 * pb[j] + pc[j]; h2r[64 * j] = pg8::cvt4_fp8(xv[q][j].x, xv[q][j].y, xv[q][j].z, xv[q][j].w); }
                }
                float pl[2][4];
#pragma unroll
                for (int k = 0; k < 4; ++k) {
                    float d8[2][8];
                    asm volatile("" ::: "memory");
#pragma unroll
                    for (int i = 0; i < 8; ++i) { const int e_ = k + 4 * i; pg8::f32x2 a2 = {0.f, 0.f}, b2 = {0.f, 0.f};
#pragma unroll
                        for (int j = 0; j < 4; ++j) { const f32x4 wv = *(const LAS f32x4*)(wrT + e_ * 1028 + 4 * lane + 256 * j);
                            a2 = __builtin_elementwise_fma((pg8::f32x2){xv[0][j].x, xv[0][j].y}, (pg8::f32x2){wv.x, wv.y}, a2); a2 = __builtin_elementwise_fma((pg8::f32x2){xv[0][j].z, xv[0][j].w}, (pg8::f32x2){wv.z, wv.w}, a2);
                            b2 = __builtin_elementwise_fma((pg8::f32x2){xv[1][j].x, xv[1][j].y}, (pg8::f32x2){wv.x, wv.y}, b2); b2 = __builtin_elementwise_fma((pg8::f32x2){xv[1][j].z, xv[1][j].w}, (pg8::f32x2){wv.z, wv.w}, b2); }
                        d8[0][i] = a2.x + a2.y; d8[1][i] = b2.x + b2.y; }
#pragma unroll
                    for (int q = 0; q < 2; ++q) {
#pragma unroll
                        for (int i = 0; i < 4; ++i) { auto r = __builtin_amdgcn_permlane32_swap(__float_as_uint(d8[q][i]), __float_as_uint(d8[q][i + 4]), false, false); d8[q][i] = __uint_as_float(r[0]) + __uint_as_float(r[1]); }
#pragma unroll
                        for (int i = 0; i < 2; ++i) { auto r = __builtin_amdgcn_permlane16_swap(__float_as_uint(d8[q][i]), __float_as_uint(d8[q][i + 2]), false, false); d8[q][i] = __uint_as_float(r[0]) + __uint_as_float(r[1]); }
                        { const bool up = (lane & 8) != 0; const float keep = up ? d8[q][1] : d8[q][0], send = up ? d8[q][0] : d8[q][1]; pl[q][k] = keep + dppf<0x140>(send); } }
                }
#pragma unroll
                for (int q = 0; q < 2; ++q) {
#define RSTEP(SB, N, CTL) _Pragma("unroll") for (int k = 0; k < N; ++k) { const bool up = (lane & SB) != 0; const float keep = up ? pl[q][k + N] : pl[q][k], send = up ? pl[q][k] : pl[q][k + N]; pl[q][k] = keep + dppf<CTL>(send); }
                    RSTEP(4, 2, 0x141) RSTEP(2, 1, 0x4E)
#undef RSTEP
                    const int e = (lane >> 1) & 31;
                    const float lg = pl[q][0] + dppf<0xB1>(pl[q][0]) + b_router[e];
                    if ((lane & 1) == 0) lgs[(wave * 8 + rr + q) * 33 + e] = lg; }
            }
            __syncthreads();
            if (tid < 64) {
                float v[32];
#pragma unroll
                for (int e = 0; e < 32; ++e) v[e] = lgs[tid * 33 + e];
                float pv_ = 3.0e38f; int pi = -1; float tv[4]; int ti[4];
#pragma unroll
                for (int k = 0; k < 4; ++k) { float bv = -3.0e38f; int bi = 0;
#pragma unroll
                    for (int e = 31; e >= 0; --e) { const bool ok = (v[e] < pv_) || (v[e] == pv_ && e > pi); if (ok && v[e] >= bv) { bv = v[e]; bi = e; } }
                    tv[k] = bv; ti[k] = bi; pv_ = bv; pi = bi; }
                float ex[4], den = 0.f;
#pragma unroll
                for (int k = 0; k < 4; ++k) { ex[k] = __builtin_amdgcn_exp2f((tv[k] - tv[0]) * LOG2E); den += ex[k]; }
                const float inv = 1.0f / den;
#pragma unroll
                for (int k = 0; k < 4; ++k) { const unsigned lp = atomicAdd((unsigned*)&lcnt[ti[k]], 1u); asg[(tid * 4 + k) * 2] = (unsigned)ti[k] | (lp << 8); asg[(tid * 4 + k) * 2 + 1] = __float_as_uint(ex[k] * inv); }
            }
            __syncthreads();
            if (tid < 32) lcnt[32 + tid] = __hip_atomic_fetch_add(gcnt_o + 64 * tid, lcnt[tid], RLX_AGENT);
            __syncthreads();
            if (tid < 256) { const unsigned a = asg[tid * 2], wbits = asg[tid * 2 + 1]; const unsigned e = a & 255u, pos = lcnt[32 + e] + (a >> 8); const int m = ch * 64 + (tid >> 2);
                rowtok_o[e * CAP + pos] = m; v2u sl; sl.x = (e << 16) | pos; sl.y = wbits; slot_o[(size_t)m * 4 + (tid & 3)] = sl; }
            __syncthreads();
        }
    }
    SEAM(6);

    LAS int* mtab = (LAS int*)(L + MOETAB_OFF);
    if (IN(7) || IN(8) || IN(9)) { PHASE_PTRS();
        if (tid < 32) mtab[80 + tid] = (int)__hip_atomic_load(gcnt + 64 * tid, RLX_AGENT);
        __syncthreads();
        if (tid == 0) { int rb = 0; for (int e = 0; e < 32; ++e) { mtab[e] = rb; mtab[40 + e] = rb * 256; rb += (mtab[80 + e] + 255) >> 8; } mtab[32] = rb; mtab[72] = rb * 256; }
        __syncthreads();
    }

    if (IN(7)) { PHASE_PTRS();
        pg8::Gemm g{H2, W1T, D / 2, D / 2, D / 2, 128}; pg8::MoeOrder<true> S{mtab, ROWTOK, 8, G, bx};
        pg8::EpiSwiglu E{(unsigned char*)HID, b_e1};
        pg8::gemm_phase<pg8::EpiSwiglu, pg8::MoeOrder<true>, 1>(L, g, S, E);
    }
    SEAM(7);

    if (IN(8)) { PHASE_PTRS();
        pg8::Gemm g{HID, W2T, D / 2, D / 2, D / 2, 128}; pg8::MoeOrder<false> S{mtab, ROWTOK, 4, G, bx};
        pg8::EpiStore E{Yb, D, b_e2, 256, 1024, pg8::W8_INV, 1};
        pg8::gemm_phase<pg8::EpiStore, pg8::MoeOrder<false>, 1>(L, g, S, E);
    }
    SEAM(8);

    if (IN(9)) { PHASE_PTRS();
        for (int b = 0; b < BATCH; ++b) {
            f32x4 pa[4], pf[4];
#pragma unroll
            for (int j = 0; j < 4; ++j) { const int c = 4 * lane + 256 * j;
                pa[j] = *(const f32x4*)(g_post_mix + c) * *(const f32x4*)(MOD + b * 6144 + 2048 + c);
                pf[j] = *(const f32x4*)(g_post_ffn + c) * *(const f32x4*)(MOD + b * 6144 + 5120 + c); }
            for (int m = b * SEQ + gw; m < (b + 1) * SEQ; m += NGW) {
                v2u sl[4];
#pragma unroll
                for (int k = 0; k < 4; ++k) sl[k] = SLOT[(size_t)m * 4 + k];
                v2u rm[4]; f32x4 xv[4];
#pragma unroll
                for (int j = 0; j < 4; ++j) { rm[j] = __builtin_nontemporal_load((const v2u*)(MIXED + (size_t)m * D) + lane + 64 * j); xv[j] = __builtin_nontemporal_load((const f32x4*)(x + (size_t)m * D) + lane + 64 * j); }
                f32x4 ff[4];
#pragma unroll
                for (int j = 0; j < 4; ++j) ff[j] = (f32x4){0.f, 0.f, 0.f, 0.f};
#pragma unroll
                for (int k = 0; k < 4; ++k) { const int e = (int)(sl[k].x >> 16), pos = (int)(sl[k].x & 0xffffu); const float w = __uint_as_float(sl[k].y);
                    const int prow = mtab[40 + e] + pos; const unsigned* yr = (const unsigned*)((const unsigned char*)Yb + (size_t)prow * D) + lane;
#pragma unroll
                    for (int j = 0; j < 4; ++j) { const int u = (int)__builtin_nontemporal_load(yr + 64 * j); const pg8::f32x2 lo = __builtin_amdgcn_cvt_pk_f32_fp8(u, false), hi2 = __builtin_amdgcn_cvt_pk_f32_fp8(u, true);
                        ff[j] += (f32x4){lo.x, lo.y, hi2.x, hi2.y} * w; } }
                float s = 0.f, sm = 0.f; f32x4 mx[4];
#pragma unroll
                for (int j = 0; j < 4; ++j) { mx[j] = (f32x4){pg8::bf_lo(rm[j].x), pg8::bf_hi(rm[j].x), pg8::bf_lo(rm[j].y), pg8::bf_hi(rm[j].y)};
                    sm += (mx[j].x * mx[j].x + mx[j].y * mx[j].y) + (mx[j].z * mx[j].z + mx[j].w * mx[j].w); s += (ff[j].x * ff[j].x + ff[j].y * ff[j].y) + (ff[j].z * ff[j].z + ff[j].w * ff[j].w); }
                const float rstdm = 1.0f / sqrtf(wave_sum_fast(sm) * (1.0f / D) + RMS_EPS);
                const float rstd = 1.0f / sqrtf(wave_sum_fast(s) * (1.0f / D) + RMS_EPS);
                f32x4* orow = (f32x4*)(x1o + (size_t)m * D) + lane;
#pragma unroll
                for (int j = 0; j < 4; ++j) __builtin_nontemporal_store(xv[j] + pa[j] * (mx[j] * rstdm) + pf[j] * (ff[j] * rstd), orow + 64 * j);
            }
        }
    }
#undef IN
#undef SEAM
}

extern "C" void kernel_launch(void* const* d_in, const int* in_sizes, int n_in, void* d_out, int out_size, void* d_ws, size_t ws_size, hipStream_t stream) {
    static int grid = 0;
    if (grid == 0) {
        if (n_in != 21 || in_sizes[0] != M * D || out_size != M * D || ws_size < WS_END) { fprintf(stderr, "kernel_launch: unexpected shapes (n_in %d, in0 %d, out %d, ws %zu); nothing launched\n", n_in, n_in > 0 ? in_sizes[0] : -1, out_size, ws_size); grid = -1; return; }
        int dev = 0, cus = 0, per_cu = 0;
        if (hipGetDevice(&dev) != hipSuccess || hipDeviceGetAttribute(&cus, hipDeviceAttributeMultiprocessorCount, dev) != hipSuccess) { grid = -1; return; }
        if (hipFuncSetAttribute((const void*)mk_fwd, hipFuncAttributeMaxDynamicSharedMemorySize, LDS_BYTES) != hipSuccess) { fprintf(stderr, "kernel_launch: hipFuncSetAttribute failed\n"); grid = -1; return; }
        if (hipOccupancyMaxActiveBlocksPerMultiprocessor(&per_cu, (const void*)mk_fwd, NWAVES * 64, LDS_BYTES) != hipSuccess || per_cu < 1) { fprintf(stderr, "kernel_launch: occupancy query reports %d workgroups per CU\n", per_cu); per_cu = 1; }
        (void)hipGetLastError();
        grid = cus;
    }
    if (grid < 0) return;
    if (hipMemsetAsync((char*)d_ws + WS_CTL, 0, CTL_ZERO_BYTES, stream) != hipSuccess) { fprintf(stderr, "kernel_launch: memset failed\n"); return; }
    Args a{};
    for (int i = 0; i < 21; ++i) a.in[i] = (const float*)d_in[i];
    a.out = (float*)d_out; a.ws = (unsigned char*)d_ws;
    if (N_LAUNCHES == 1) {
        a.ph_lo = 0; a.ph_hi = N_PHASES; a.li = 0;
        void* kargs[] = {&a};
        hipError_t e = hipLaunchCooperativeKernel((const void*)mk_fwd, dim3(grid), dim3(NWAVES * 64), kargs, LDS_BYTES, stream);
        if (e != hipSuccess) fprintf(stderr, "kernel_launch: cooperative launch failed: %s (grid %d)\n", hipGetErrorString(e), grid);
        if (PROBE_REP >= 0) { Args a2 = a; a2.ph_lo = PROBE_REP; a2.ph_hi = PROBE_REP + 1; a2.li = 1; hipLaunchKernelGGL(mk_fwd, dim3(grid), dim3(NWAVES * 64), LDS_BYTES, stream, a2); }
    } else {
        for (int li = 0; li < N_PHASES; ++li) { a.ph_lo = li; a.ph_hi = li + 1; a.li = li; hipLaunchKernelGGL(mk_fwd, dim3(grid), dim3(NWAVES * 64), LDS_BYTES, stream, a); }
    }
}
```

```cpp
#include <hip/hip_runtime.h>
#include <hip/hip_bf16.h>
#include <cstdio>
#include <cstdint>

#ifndef MK_N_LAUNCHES
#define MK_N_LAUNCHES 1
#endif
#ifndef PROBE_REP
#define PROBE_REP -1
#endif

constexpr int D = 1024, BATCH = 4, SEQ = 4096, M = BATCH * SEQ;
constexpr int NCAT = 5120;
constexpr int NE = 32, TOPK = 4, CAP = 16384;
constexpr int MAXRB = M * TOPK / 256 + NE;
constexpr float RMS_EPS = 1e-6f;
constexpr float LOG2E = 1.4426950408889634f;
constexpr float QSCALE = 0.125f * LOG2E;

namespace pg8 {
#define PG8_LAS __attribute__((address_space(3)))
typedef unsigned short bf16_t;
typedef short bf16x8 __attribute__((ext_vector_type(8)));
typedef float f32x4 __attribute__((ext_vector_type(4)));
typedef float f32x2 __attribute__((ext_vector_type(2)));
typedef unsigned u32x4 __attribute__((ext_vector_type(4)));
constexpr int BM = 256, BK = 64, HALF = 128, HTB = HALF * BK * 2, STAGE_BYTES = 8 * HTB, NXCD = 8, WGM = 8;
constexpr int BIAS_LDS = STAGE_BYTES;
constexpr int TOK_LDS = STAGE_BYTES + 2048;
constexpr int UNIT_LDS = STAGE_BYTES + 4096;

__host__ __device__ __forceinline__ int lds_byte(int r, int c) { const int st = (r >> 4) * 2 + (c >> 5), rr = r & 15, cc = c & 31, ob = rr * 64 + cc * 2; return st * 1024 + (ob ^ (((ob >> 9) & 1) << 5)); }
__host__ __device__ __forceinline__ void stage_rc(int b, int& R, int& C) { const int st = b / 1024, sb = b % 1024, swz = sb ^ (((sb >> 9) & 1) << 5); R = (st >> 1) * 16 + swz / 64; C = (st & 1) * 32 + (swz % 64) / 2; }
__host__ __device__ __forceinline__ int perm32(int rho) { const int n = rho >> 4, i = rho & 15; return 8 * (i >> 2) + 4 * n + (i & 3); }

struct Unit { int arow0, brow0, ak0, bk0, x0, x1, x2, x3; };
struct Gemm { const bf16_t* A; const bf16_t* Bt; int lda, ldb, K; int hrowsB; };

__device__ __forceinline__ int xcd_remap(int L, int nwg) { const int q = nwg / NXCD, r = nwg % NXCD, xcd = L % NXCD, off = L / NXCD; return (xcd < r ? xcd * (q + 1) : r * (q + 1) + (xcd - r) * q) + off; }
__device__ __forceinline__ void tile_of(int wgid, int nM, int nN, int& pm, int& pn) {
    const int nig = WGM * nN, gid = wgid / nig, fm = gid * WGM, gsz = (nM - fm) < WGM ? (nM - fm) : WGM;
    pm = fm + ((wgid % nig) % gsz); pn = (wgid % nig) / gsz;
}
__device__ __forceinline__ unsigned cvt_pk_bf16(float lo, float hi) { typedef __bf16 bf16x2_t __attribute__((ext_vector_type(2))); f32x2 v = {lo, hi}; bf16x2_t b = __builtin_convertvector(v, bf16x2_t); return __builtin_bit_cast(unsigned, b); }
__device__ __forceinline__ float bf_lo(unsigned u) { return __uint_as_float(u << 16); }
__device__ __forceinline__ float bf_hi(unsigned u) { return __uint_as_float(u & 0xffff0000u); }
__device__ __forceinline__ unsigned cvt4_fp8(float a, float b, float c, float d) { int w = 0; w = __builtin_amdgcn_cvt_pk_fp8_f32(a, b, w, false); w = __builtin_amdgcn_cvt_pk_fp8_f32(c, d, w, true); return (unsigned)w; }
constexpr float W8_SCALE = 64.0f, W8_INV = 1.0f / 64.0f;
__device__ __forceinline__ float sigmoidf_fast(float x) { return __builtin_amdgcn_rcpf(1.0f + __builtin_amdgcn_exp2f(-x * LOG2E)); }

struct PlainOrder {
    int nM, nN, G, c, bmul;
    __device__ __forceinline__ bool next(int i, Unit& u) const {
        const int nwg = nM * nN; const long L = (long)i * G + c; if (L >= nwg) return false;
        int pm, pn; tile_of(xcd_remap((int)L, nwg), nM, nN, pm, pn);
        u.arow0 = pm * BM; u.brow0 = pn * bmul; u.ak0 = 0; u.bk0 = 0; u.x0 = 0; u.x1 = pm * BM; u.x2 = pn * bmul; u.x3 = 0; return true;
    }
    static constexpr bool TOK = false; static constexpr int DFLOW = 0;
    __device__ __forceinline__ const int* tok_src(const Unit&, int) const { return nullptr; }
    __device__ __forceinline__ unsigned aoff(const Unit& u, int h, int R, int C, int lda, const PG8_LAS int*) const { return (unsigned)(((u.arow0 + HALF * h + R) * lda + u.ak0 + C) * 2); }
};
__device__ __forceinline__ void flag_wait(const unsigned* p, unsigned need) {
    unsigned v; asm volatile("s_load_dword %0, %1, 0x0 glc\n\ts_waitcnt lgkmcnt(0)" : "=s"(v) : "s"(p) : "memory"); if (v >= need) return;
    for (unsigned sp = 0; sp < (1u << 22); ++sp) { unsigned w; asm volatile("global_load_dword %0, %1, %2 sc1\n\ts_waitcnt vmcnt(0)" : "=v"(w) : "v"(0u), "s"(p) : "memory"); if ((unsigned)__builtin_amdgcn_readfirstlane((int)w) >= need) break; __builtin_amdgcn_s_sleep(2); }
}
constexpr int MOE_UNITS = 64;
typedef int i32x4 __attribute__((ext_vector_type(4)));
template <bool GATHER> struct MoeOrder {
    const PG8_LAS int* tab; const int* rowtok; int npn, G, c; const PG8_LAS i32x4* utab;
    int lx, lrank, rot; unsigned* flags;
    static constexpr int DFLOW = GATHER ? 1 : 2;
    __device__ __forceinline__ void build(int tid) const {
        if (tid < MOE_UNITS) { i32x4 d = {-1, 0, 0, 0};
            const int nrb = tab[32]; const int nwg = nrb * npn; const long L = (long)tid * G + c;
            int rbg = -1, pn = 0;
            if (lx >= 0) { const int n = G / NXCD, rb0 = (lx * nrb) / NXCD, rb1 = ((lx + 1) * nrb) / NXCD; int lr = (lrank - (rb1 - rb0) * rot) % n; lr += (lr < 0) ? n : 0;
                const int lu = lr + n * tid; if (lu < (rb1 - rb0) * npn) { rbg = rb0 + lu / npn; pn = lu % npn; } }
            else if (L < nwg) { const int wg = xcd_remap((int)L, nwg); rbg = wg / npn; pn = wg % npn; }
            if (rbg >= 0) {
                int e = 0;
#pragma unroll
                for (int j = 1; j < 32; ++j) e += (rbg >= tab[j]) ? 1 : 0;
                const int rb = rbg - tab[e]; d = (i32x4){e, tab[40 + e] + rb * BM, pn, rb * BM}; }
            ((PG8_LAS i32x4*)utab)[tid] = d; }
        __syncthreads();
    }
    __device__ __forceinline__ bool next(int i, Unit& u) const {
        if (i >= MOE_UNITS) return false;
        const i32x4 d = utab[i]; const int e = __builtin_amdgcn_readfirstlane(d.x); if (e < 0) return false;
        const int prow0 = __builtin_amdgcn_readfirstlane(d.y), pn = __builtin_amdgcn_readfirstlane(d.z), r0 = __builtin_amdgcn_readfirstlane(d.w);
        u.x0 = e; u.x1 = prow0; u.x2 = pn; u.x3 = r0; u.arow0 = prow0; u.brow0 = (e * npn + pn) * BM; u.ak0 = 0; u.bk0 = 0; return true;
    }
    static constexpr bool TOK = GATHER;
    __device__ __forceinline__ const int* tok_src(const Unit& u, int lane) const { return rowtok + u.x0 * CAP + u.x3 + 4 * lane; }
    __device__ __forceinline__ unsigned aoff(const Unit& u, int h, int R, int C, int lda, const PG8_LAS int* slot) const {
        if constexpr (GATHER) { const int rl = HALF * h + R; const int cnt = tab[80 + u.x0]; int tok = slot[rl]; tok = (u.x3 + rl < cnt) ? tok : 0; return (unsigned)((tok * lda + C) * 2); }
        else return (unsigned)(((u.arow0 + HALF * h + R) * lda + C) * 2);
    }
};

struct EpiProj {
    static constexpr bool PERM = true; bf16_t* QKV;
    __device__ __forceinline__ bool bias_on(const Unit&) const { return false; }
    __device__ __forceinline__ const float* bias_src(const Unit&, int) const { return nullptr; }
    __device__ __forceinline__ void operator()(const f32x4 (&acc)[2][2][4][2], const Unit& u, int wr, int wc, int fr, int fq, const PG8_LAS float*) const {
        const int row0 = u.x1 + wr * 64 + fr, colt = u.x2, col0 = colt + wc * 32 + 8 * fq;
        const float qs = (colt < 512 || (colt >= 1536 && colt < 2048)) ? QSCALE : 1.0f;
        const int bb = row0 / SEQ, s0 = row0 % SEQ;
#pragma unroll
        for (int ai = 0; ai < 2; ++ai)
#pragma unroll
            for (int m = 0; m < 4; ++m) { const int srow = s0 + ai * HALF + m * 16;
#pragma unroll
                for (int bj = 0; bj < 2; ++bj) { f32x4 v0 = acc[ai][bj][m][0], v1 = acc[ai][bj][m][1]; const int col = col0 + bj * HALF;
                    v0 = v0 * qs; v1 = v1 * qs;
                    u32x4 w; w.x = cvt_pk_bf16(v0[0], v0[1]); w.y = cvt_pk_bf16(v0[2], v0[3]); w.z = cvt_pk_bf16(v1[0], v1[1]); w.w = cvt_pk_bf16(v1[2], v1[3]);
                    { const int kind = col >> 9, hh = (col >> 6) & 7, d = col & 63; *(u32x4*)(QKV + ((size_t)((kind * BATCH + bb) * 8 + hh) * SEQ + srow) * 64 + d) = w; } } }
    }
};
struct EpiGate {
    static constexpr bool PERM = true; unsigned char* GATE; const float* bgate;
    __device__ __forceinline__ bool bias_on(const Unit&) const { return true; }
    __device__ __forceinline__ const float* bias_src(const Unit& u, int lane) const { return bgate + u.x2 + 4 * lane; }
    __device__ __forceinline__ void operator()(const f32x4 (&acc)[2][2][4][2], const Unit& u, int wr, int wc, int fr, int fq, const PG8_LAS float* bl) const {
        const int row0 = u.x1 + wr * 64 + fr;
        f32x4 bv[2][2];
#pragma unroll
        for (int bj = 0; bj < 2; ++bj)
#pragma unroll
            for (int n = 0; n < 2; ++n) bv[bj][n] = *(const PG8_LAS f32x4*)(bl + bj * HALF + wc * 32 + 8 * fq + 4 * n) * (-LOG2E);
#pragma unroll
        for (int ai = 0; ai < 2; ++ai)
#pragma unroll
            for (int m = 0; m < 4; ++m) { u32x4 gq;
#pragma unroll
                for (int bj = 0; bj < 2; ++bj) { f32x4 v0 = acc[ai][bj][m][0] * (-LOG2E * W8_INV) + bv[bj][0], v1 = acc[ai][bj][m][1] * (-LOG2E * W8_INV) + bv[bj][1];
#pragma unroll
                    for (int k = 0; k < 4; ++k) { v0[k] = __builtin_amdgcn_rcpf(__builtin_fmaf(__builtin_amdgcn_exp2f(v0[k]), 1.0f / 255.0f, 1.0f / 255.0f)); v1[k] = __builtin_amdgcn_rcpf(__builtin_fmaf(__builtin_amdgcn_exp2f(v1[k]), 1.0f / 255.0f, 1.0f / 255.0f)); }
                    unsigned lo_ = 0u, hi_ = 0u;
                    lo_ = __builtin_amdgcn_cvt_pk_u8_f32(v0[0], 0, lo_); lo_ = __builtin_amdgcn_cvt_pk_u8_f32(v0[1], 1, lo_); lo_ = __builtin_amdgcn_cvt_pk_u8_f32(v0[2], 2, lo_); lo_ = __builtin_amdgcn_cvt_pk_u8_f32(v0[3], 3, lo_);
                    hi_ = __builtin_amdgcn_cvt_pk_u8_f32(v1[0], 0, hi_); hi_ = __builtin_amdgcn_cvt_pk_u8_f32(v1[1], 1, hi_); hi_ = __builtin_amdgcn_cvt_pk_u8_f32(v1[2], 2, hi_); hi_ = __builtin_amdgcn_cvt_pk_u8_f32(v1[3], 3, hi_);
                    gq[2 * bj] = lo_; gq[2 * bj + 1] = hi_; }
                __builtin_nontemporal_store(gq, (u32x4*)(GATE + (size_t)(row0 + ai * HALF + m * 16) * 2048 + u.x2 + wc * 64 + fq * 16)); }
    }
};
struct EpiMix2 {
    static constexpr bool PERM = true; const bf16_t* GATE; bf16_t* O;
    __device__ __forceinline__ bool bias_on(const Unit&) const { return false; }
    __device__ __forceinline__ const float* bias_src(const Unit&, int) const { return nullptr; }
    __device__ __forceinline__ void operator()(const f32x4 (&acc)[2][2][4][2], const Unit& u, int wr, int wc, int fr, int fq, const PG8_LAS float*) const {
        const int row0 = u.x1 + wr * 64 + fr, col0 = u.x2 + wc * 32 + 8 * fq;
        const int gofs = (u.x2 >> 8) * 256 + wc * 64 + fq * 16 + ((u.x2 >> 7) & 1) * 8;
        typedef unsigned u32x2 __attribute__((ext_vector_type(2)));
        u32x2 gsv[2][4], gcv[2][4];
#pragma unroll
        for (int ai = 0; ai < 2; ++ai)
#pragma unroll
            for (int m = 0; m < 4; ++m) { const unsigned char* gp = (const unsigned char*)GATE + (size_t)(row0 + ai * HALF + m * 16) * 2048 + gofs;
                gsv[ai][m] = __builtin_nontemporal_load((const u32x2*)gp); gcv[ai][m] = __builtin_nontemporal_load((const u32x2*)(gp + 1024)); }
        __builtin_amdgcn_sched_barrier(0);
#pragma unroll
        for (int ai = 0; ai < 2; ++ai)
#pragma unroll
            for (int m = 0; m < 4; ++m) { const size_t row = (size_t)(row0 + ai * HALF + m * 16);
                const u32x2 gs = gsv[ai][m], gc = gcv[ai][m];
                const f32x4 a0 = acc[ai][0][m][0], a1 = acc[ai][0][m][1], c0 = acc[ai][1][m][0], c1 = acc[ai][1][m][1];
                constexpr float q = 1.0f / 255.0f;
#define U8F(w, i) ((float)(((w) >> (8 * (i))) & 0xffu) * q)
                u32x2 w;
                w.x = cvt4_fp8(a0[0] * U8F(gs.x, 0) + c0[0] * U8F(gc.x, 0), a0[1] * U8F(gs.x, 1) + c0[1] * U8F(gc.x, 1), a0[2] * U8F(gs.x, 2) + c0[2] * U8F(gc.x, 2), a0[3] * U8F(gs.x, 3) + c0[3] * U8F(gc.x, 3));
                w.y = cvt4_fp8(a1[0] * U8F(gs.y, 0) + c1[0] * U8F(gc.y, 0), a1[1] * U8F(gs.y, 1) + c1[1] * U8F(gc.y, 1), a1[2] * U8F(gs.y, 2) + c1[2] * U8F(gc.y, 2), a1[3] * U8F(gs.y, 3) + c1[3] * U8F(gc.y, 3));
#undef U8F
                *(u32x2*)((unsigned char*)O + row * D + col0) = w; }
    }
};
struct EpiStore {
    static constexpr bool PERM = true; bf16_t* O; int ldc; const float* bias; int colmul; int bias_ld; float scale; int out8;
    __device__ __forceinline__ bool bias_on(const Unit&) const { return bias != nullptr; }
    __device__ __forceinline__ const float* bias_src(const Unit& u, int lane) const { return bias + (size_t)u.x0 * bias_ld + u.x2 * colmul + 4 * lane; }
    __device__ __forceinline__ void operator()(const f32x4 (&acc)[2][2][4][2], const Unit& u, int wr, int wc, int fr, int fq, const PG8_LAS float* bl) const {
        const int row0 = u.x1 + wr * 64 + fr, col0 = u.x2 * colmul + wc * 32 + 8 * fq;
        f32x4 bv[2][2];
#pragma unroll
        for (int bj = 0; bj < 2; ++bj)
#pragma unroll
            for (int n = 0; n < 2; ++n) bv[bj][n] = bias ? *(const PG8_LAS f32x4*)(bl + bj * HALF + wc * 32 + 8 * fq + 4 * n) : (f32x4){0.f, 0.f, 0.f, 0.f};
#pragma unroll
        for (int ai = 0; ai < 2; ++ai)
#pragma unroll
            for (int m = 0; m < 4; ++m) { bf16_t* rowp = O + (size_t)(row0 + ai * HALF + m * 16) * ldc + col0;
                if (out8) {
                    u32x4 w8;
                    { const f32x4 v0 = acc[ai][0][m][0] * scale + bv[0][0], v1 = acc[ai][0][m][1] * scale + bv[0][1]; w8.x = cvt4_fp8(v0[0], v0[1], v0[2], v0[3]); w8.y = cvt4_fp8(v1[0], v1[1], v1[2], v1[3]); }
                    { const f32x4 v0 = acc[ai][1][m][0] * scale + bv[1][0], v1 = acc[ai][1][m][1] * scale + bv[1][1]; w8.z = cvt4_fp8(v0[0], v0[1], v0[2], v0[3]); w8.w = cvt4_fp8(v1[0], v1[1], v1[2], v1[3]); }
                    *(u32x4*)((unsigned char*)O + (size_t)(row0 + ai * HALF + m * 16) * ldc + u.x2 * colmul + wc * 64 + fq * 16) = w8; continue; }
#pragma unroll
                for (int bj = 0; bj < 2; ++bj) { const f32x4 v0 = acc[ai][bj][m][0] * scale + bv[bj][0], v1 = acc[ai][bj][m][1] * scale + bv[bj][1];
                    u32x4 w; w.x = cvt_pk_bf16(v0[0], v0[1]); w.y = cvt_pk_bf16(v0[2], v0[3]); w.z = cvt_pk_bf16(v1[0], v1[1]); w.w = cvt_pk_bf16(v1[2], v1[3]);
                    *(u32x4*)(rowp + bj * HALF) = w; } }
    }
};
struct EpiSwiglu {
    static constexpr bool PERM = true; unsigned char* O; const float* b1;
    __device__ __forceinline__ bool bias_on(const Unit&) const { return true; }
    __device__ __forceinline__ const float* bias_src(const Unit& u, int lane) const { return b1 + (size_t)u.x0 * 2048 + u.x2 * HALF + 4 * (lane & 31) + 1024 * (lane >> 5); }
    __device__ __forceinline__ void operator()(const f32x4 (&acc)[2][2][4][2], const Unit& u, int wr, int wc, int fr, int fq, const PG8_LAS float* bl) const {
        const int row0 = u.x1 + wr * 64 + fr, col0 = u.x2 * HALF + wc * 32 + 8 * fq;
        const PG8_LAS float* bb = bl + wc * 32 + 8 * fq;
        constexpr float C = 1.702f * LOG2E, KG = C * W8_INV, KU = W8_INV / C, GMAX = 7.0f * C, ULO = -6.0f / C, UHI = 8.0f / C;
        f32x4 bg[2], bu[2];
#pragma unroll
        for (int n = 0; n < 2; ++n) { bg[n] = *(const PG8_LAS f32x4*)(bb + 4 * n) * C; bu[n] = (*(const PG8_LAS f32x4*)(bb + HALF + 4 * n) + 1.0f) * (1.0f / C); }
#pragma unroll
        for (int ai = 0; ai < 2; ++ai)
#pragma unroll
            for (int m = 0; m < 4; ++m) { unsigned char* rowp = O + (size_t)(row0 + ai * HALF + m * 16) * D + col0; f32x4 o[2];
#pragma unroll
                for (int n = 0; n < 2; ++n) { const f32x4 ga = acc[ai][0][m][n], ua = acc[ai][1][m][n];
#pragma unroll
                    for (int k2 = 0; k2 < 4; k2 += 2) {
                        const f32x2 g2 = __builtin_elementwise_fma((f32x2){ga[k2], ga[k2 + 1]}, (f32x2){KG, KG}, (f32x2){bg[n][k2], bg[n][k2 + 1]});
                        const f32x2 u2 = __builtin_elementwise_fma((f32x2){ua[k2], ua[k2 + 1]}, (f32x2){KU, KU}, (f32x2){bu[n][k2], bu[n][k2 + 1]});
                        const f32x2 gg = {fminf(g2.x, GMAX), fminf(g2.y, GMAX)}, w2 = {fminf(fmaxf(u2.x, ULO), UHI), fminf(fmaxf(u2.y, ULO), UHI)};
                        const f32x2 d2 = (f32x2){__builtin_amdgcn_exp2f(-gg.x), __builtin_amdgcn_exp2f(-gg.y)} + (f32x2){1.0f, 1.0f};
                        const f32x2 r2 = {__builtin_amdgcn_rcpf(d2.x), __builtin_amdgcn_rcpf(d2.y)};
                        const f32x2 o2 = (gg * w2) * r2;
                        o[n][k2] = o2.x; o[n][k2 + 1] = o2.y; } }
                typedef unsigned u32x2 __attribute__((ext_vector_type(2)));
                u32x2 w; w.x = cvt4_fp8(o[0][0], o[0][1], o[0][2], o[0][3]); w.y = cvt4_fp8(o[1][0], o[1][1], o[1][2], o[1][3]);
                *(u32x2*)rowp = w; }
    }
};

typedef int v8i __attribute__((ext_vector_type(8)));
template <class Epi, class Sched, int MODE = 0>
__device__ __forceinline__ void gemm_phase(PG8_LAS unsigned char* lds, const Gemm g, const Sched& S, const Epi& E) {
    constexpr bool FP8 = (MODE == 1);
    int tid = threadIdx.x; asm volatile("" : "+v"(tid));
    const int wid = __builtin_amdgcn_readfirstlane(tid >> 6), lane = tid & 63, wr = wid >> 2, wc = wid & 3, fr = lane & 15, fq = lane >> 4;
    const int nt = g.K / BK;
    int Rs[2], Cs[2]; unsigned voffB[2];
#pragma unroll
    for (int i = 0; i < 2; ++i) { stage_rc(tid * 16 + i * 8192, Rs[i], Cs[i]); const int Rb = Epi::PERM ? ((Rs[i] & ~31) + perm32(Rs[i] & 31)) : Rs[i]; voffB[i] = (unsigned)(Rb * g.ldb + Cs[i]) * 2u; }
    const size_t kstep = (size_t)(BK * 2);
    const size_t hstepB = (size_t)g.hrowsB * g.ldb * 2;
    const unsigned ldsw = (unsigned)wid * 1024u;
    const int aoff = lds_byte(wr * 64 + fr, fq * 8), boff = lds_byte(wc * 32 + fr, fq * 8);
#define PG8_SA(b, h) (((b) * 2 + (h)) * HTB)
#define PG8_SB(b, h) ((4 + (b) * 2 + (h)) * HTB)
#define PG8_STAGE(bufoff, gbase, voff) do { const char* gb_ = (const char*)(gbase); asm volatile("" : "+s"(gb_));     \
        _Pragma("unroll") for (int _i = 0; _i < 2; ++_i) { unsigned vo_ = (voff)[_i]; asm volatile("" : "+v"(vo_)); \
        __builtin_amdgcn_global_load_lds((const unsigned*)(gb_ + vo_), (PG8_LAS unsigned*)(lds + (bufoff) + ldsw + _i * 8192), 16, 0, 0); } } while (0)
#define PG8_LDA(dst, b, h) do { _Pragma("unroll") for (int m = 0; m < 4; ++m) _Pragma("unroll") for (int k = 0; k < 2; ++k) dst[m][k] = *(const PG8_LAS bf16x8*)(lds + PG8_SA(b, h) + aoff + m * 2048 + k * 1024); } while (0)
#define PG8_LDB(dst, b, h) do { _Pragma("unroll") for (int n = 0; n < 2; ++n) _Pragma("unroll") for (int k = 0; k < 2; ++k) dst[n][k] = *(const PG8_LAS bf16x8*)(lds + PG8_SB(b, h) + boff + n * 2048 + k * 1024); } while (0)
#define PG8_MMA(ai, bj, At, Bt) do { __builtin_amdgcn_s_setprio(1); _Pragma("unroll") for (int m = 0; m < 4; ++m) _Pragma("unroll") for (int n = 0; n < 2; ++n) _Pragma("unroll") for (int k = 0; k < 2; ++k) \
        acc[ai][bj][m][n] = __builtin_amdgcn_mfma_f32_16x16x32_bf16(Bt[n][k], At[m][k], acc[ai][bj][m][n], 0, 0, 0); __builtin_amdgcn_s_setprio(0); } while (0)
#define PG8_MMAZ(ai, bj, At, Bt) do { __builtin_amdgcn_s_setprio(1); _Pragma("unroll") for (int m = 0; m < 4; ++m) _Pragma("unroll") for (int n = 0; n < 2; ++n) { \
        acc[ai][bj][m][n] = __builtin_amdgcn_mfma_f32_16x16x32_bf16(Bt[n][0], At[m][0], (f32x4){0.f, 0.f, 0.f, 0.f}, 0, 0, 0); acc[ai][bj][m][n] = __builtin_amdgcn_mfma_f32_16x16x32_bf16(Bt[n][1], At[m][1], acc[ai][bj][m][n], 0, 0, 0); } __builtin_amdgcn_s_setprio(0); } while (0)
#define PG8_LDA8(dst, b, h) do { _Pragma("unroll") for (int m = 0; m < 4; ++m) { const u32x4 lo_ = *(const PG8_LAS u32x4*)(lds + PG8_SA(b, h) + aoff + m * 2048), hi_ = *(const PG8_LAS u32x4*)(lds + PG8_SA(b, h) + aoff + m * 2048 + 1024); \
        dst[m] = (v8i){(int)lo_.x, (int)lo_.y, (int)lo_.z, (int)lo_.w, (int)hi_.x, (int)hi_.y, (int)hi_.z, (int)hi_.w}; } } while (0)
#define PG8_LDB8(dst, b, h) do { _Pragma("unroll") for (int n = 0; n < 2; ++n) { const u32x4 lo_ = *(const PG8_LAS u32x4*)(lds + PG8_SB(b, h) + boff + n * 2048), hi_ = *(const PG8_LAS u32x4*)(lds + PG8_SB(b, h) + boff + n * 2048 + 1024); \
        dst[n] = (v8i){(int)lo_.x, (int)lo_.y, (int)lo_.z, (int)lo_.w, (int)hi_.x, (int)hi_.y, (int)hi_.z, (int)hi_.w}; } } while (0)
#define PG8_MMA8(ai, bj, At, Bt) do { asm volatile("" : "+v"(At[0]), "+v"(At[1]), "+v"(At[2]), "+v"(At[3]), "+v"(Bt[0]), "+v"(Bt[1])); \
        __builtin_amdgcn_s_setprio(1); _Pragma("unroll") for (int m = 0; m < 4; ++m) _Pragma("unroll") for (int n = 0; n < 2; ++n) \
        acc[ai][bj][m][n] = __builtin_amdgcn_mfma_scale_f32_16x16x128_f8f6f4(Bt[n], At[m], acc[ai][bj][m][n], 0, 0, 0, 0x7F7F7F7F, 0, 0x7F7F7F7F); \
        asm volatile("" : "+v"(acc[ai][bj][0][0]), "+v"(acc[ai][bj][0][1]), "+v"(acc[ai][bj][1][0]), "+v"(acc[ai][bj][1][1]), "+v"(acc[ai][bj][2][0]), "+v"(acc[ai][bj][2][1]), "+v"(acc[ai][bj][3][0]), "+v"(acc[ai][bj][3][1])); \
        __builtin_amdgcn_s_setprio(0); } while (0)
#define PG8_MMA8Z(ai, bj, At, Bt) do { asm volatile("" : "+v"(At[0]), "+v"(At[1]), "+v"(At[2]), "+v"(At[3]), "+v"(Bt[0]), "+v"(Bt[1])); \
        __builtin_amdgcn_s_setprio(1); _Pragma("unroll") for (int m = 0; m < 4; ++m) _Pragma("unroll") for (int n = 0; n < 2; ++n) \
        acc[ai][bj][m][n] = __builtin_amdgcn_mfma_scale_f32_16x16x128_f8f6f4(Bt[n], At[m], (f32x4){0.f, 0.f, 0.f, 0.f}, 0, 0, 0, 0x7F7F7F7F, 0, 0x7F7F7F7F); \
        asm volatile("" : "+v"(acc[ai][bj][0][0]), "+v"(acc[ai][bj][0][1]), "+v"(acc[ai][bj][1][0]), "+v"(acc[ai][bj][1][1]), "+v"(acc[ai][bj][2][0]), "+v"(acc[ai][bj][2][1]), "+v"(acc[ai][bj][3][0]), "+v"(acc[ai][bj][3][1])); \
        __builtin_amdgcn_s_setprio(0); } while (0)
#define PG8_WAIT_V(n) asm volatile("s_waitcnt vmcnt(" #n ")" ::: "memory")
#define PG8_WAIT_L(n) asm volatile("s_waitcnt lgkmcnt(" #n ")" ::: "memory")
#define PG8_BAR __builtin_amdgcn_s_barrier()
#define PG8_SCHED __builtin_amdgcn_sched_barrier(0)
    Unit cur, nxt; int ui = 0;
    if (!S.next(0, cur)) return;
    f32x4 acc[2][2][4][2];
    if constexpr (MODE == 2) {
#pragma unroll
    for (int a = 0; a < 2; ++a)
#pragma unroll
        for (int b = 0; b < 2; ++b)
#pragma unroll
            for (int m = 0; m < 4; ++m)
#pragma unroll
                for (int n = 0; n < 2; ++n) acc[a][b][m][n] = (f32x4){0.f, 0.f, 0.f, 0.f};
    }
    bf16x8 At[4][2], B0[2][2], B1[2][2];
    v8i At8[4], B08[2], B18[2];
    unsigned vc[2][2], vn[2][2];
#define PG8_TOKSLOT(u_) ((const PG8_LAS int*)(lds + TOK_LDS + ((u_) & 1) * 1024))
    if constexpr (Sched::TOK) {
        if (wid == 0) { __builtin_amdgcn_global_load_lds((const unsigned*)S.tok_src(cur, lane), (PG8_LAS unsigned*)(lds + TOK_LDS), 16, 0, 0);
            if (S.next(1, nxt)) __builtin_amdgcn_global_load_lds((const unsigned*)S.tok_src(nxt, lane), (PG8_LAS unsigned*)(lds + TOK_LDS + 1024), 16, 0, 0);
            PG8_WAIT_V(0); }
        PG8_BAR;
    }
    int prevrb = 0, prevrb2 = 0;
    if constexpr (Sched::DFLOW == 2) { if (S.flags) { if (wid == 0) flag_wait(S.flags + (cur.x1 >> 8), 8u); PG8_BAR; } }
#pragma unroll
    for (int h = 0; h < 2; ++h)
#pragma unroll
        for (int i = 0; i < 2; ++i) vc[h][i] = S.aoff(cur, h, Rs[i], Cs[i], g.lda, PG8_TOKSLOT(0));
    const char* const cA = (const char*)g.A;
    const char* cB = (const char*)g.Bt + ((size_t)cur.brow0 * g.ldb + cur.bk0) * 2;
    PG8_STAGE(PG8_SB(0, 0), cB, voffB); if constexpr (MODE != 2) PG8_STAGE(PG8_SB(0, 1), cB + hstepB, voffB); PG8_STAGE(PG8_SA(0, 0), cA, vc[0]); PG8_STAGE(PG8_SA(0, 1), cA, vc[1]);
    if (wr == 1) PG8_BAR;
    PG8_WAIT_V(2); PG8_BAR;
    PG8_STAGE(PG8_SB(1, 0), cB + kstep, voffB); PG8_STAGE(PG8_SA(1, 0), cA + kstep, vc[0]); if constexpr (MODE != 2) PG8_STAGE(PG8_SB(1, 1), cB + hstepB + kstep, voffB);
    if constexpr (MODE != 2) PG8_WAIT_V(6); else PG8_WAIT_V(4);
    PG8_BAR;
    for (;;) {
        const bool has_next = S.next(ui + 1, nxt);
        if constexpr (Sched::DFLOW == 1) { if (ui > 1 && S.flags && wid == 0 && lane == 0) __hip_atomic_fetch_add(S.flags + prevrb2, 1u, __ATOMIC_RELAXED, __HIP_MEMORY_SCOPE_AGENT); }
        if constexpr (Sched::DFLOW == 2) { if (has_next && S.flags && wid == 0) flag_wait(S.flags + (nxt.x1 >> 8), 8u); }
        if (wid == 0 && E.bias_on(cur)) __builtin_amdgcn_global_load_lds((const unsigned*)E.bias_src(cur, lane), (PG8_LAS unsigned*)(lds + BIAS_LDS + (ui & 1) * 1024), 16, 0, 0);
        const char* nB = cB;
        if (has_next) { nB = (const char*)g.Bt + ((size_t)nxt.brow0 * g.ldb + nxt.bk0) * 2;
#pragma unroll
            for (int h = 0; h < 2; ++h)
#pragma unroll
                for (int i = 0; i < 2; ++i) vn[h][i] = S.aoff(nxt, h, Rs[i], Cs[i], g.lda, PG8_TOKSLOT(ui + 1));
            if constexpr (Sched::TOK) { if (wid == 0) { Unit n2; if (S.next(ui + 2, n2)) __builtin_amdgcn_global_load_lds((const unsigned*)S.tok_src(n2, lane), (PG8_LAS unsigned*)(lds + TOK_LDS + (ui & 1) * 1024), 16, 0, 0); } }
        } else {
#pragma unroll
            for (int h = 0; h < 2; ++h)
#pragma unroll
                for (int i = 0; i < 2; ++i) vn[h][i] = vc[h][i];
        }
#define PG8_BODY0(MM) \
            PG8_LDB(B0, 0, 0); PG8_LDB(B1, 0, 1); PG8_SCHED; PG8_LDA(At, 0, 0); PG8_STAGE(PG8_SA(1, 1), a1, vc[1]); \
            PG8_WAIT_V(8); PG8_WAIT_L(0); PG8_BAR; MM(0, 0, At, B0); MM(0, 1, At, B1); PG8_BAR; PG8_SCHED; \
            PG8_LDA(At, 0, 1); PG8_STAGE(PG8_SB(0, 0), b2, voffB); PG8_STAGE(PG8_SB(0, 1), b2 + hstepB, voffB); PG8_STAGE(PG8_SA(0, 0), a2, w0); \
            PG8_WAIT_V(8); PG8_WAIT_L(0); PG8_BAR; MM(1, 0, At, B0); MM(1, 1, At, B1); PG8_BAR; PG8_SCHED; \
            PG8_LDB(B0, 1, 0); PG8_LDB(B1, 1, 1); PG8_SCHED; PG8_LDA(At, 1, 0); PG8_STAGE(PG8_SA(0, 1), a2, w1); \
            PG8_WAIT_V(8); PG8_WAIT_L(0); PG8_BAR; PG8_MMA(0, 0, At, B0); PG8_MMA(0, 1, At, B1); PG8_BAR; PG8_SCHED; \
            PG8_LDA(At, 1, 1); PG8_STAGE(PG8_SB(1, 0), b3, voffB); PG8_STAGE(PG8_SB(1, 1), b3 + hstepB, voffB); PG8_STAGE(PG8_SA(1, 0), a3, w0); \
            PG8_WAIT_V(8); PG8_WAIT_L(0); PG8_BAR; PG8_MMA(1, 0, At, B0); PG8_MMA(1, 1, At, B1); PG8_BAR; PG8_SCHED;
#define PG8_BODY1(MM) \
            PG8_LDB8(B08, 0, 0); PG8_LDB8(B18, 0, 1); PG8_SCHED; PG8_LDA8(At8, 0, 0); PG8_STAGE(PG8_SA(1, 1), a1, vc[1]); \
            PG8_WAIT_V(8); PG8_WAIT_L(0); PG8_BAR; PG8_SCHED; MM(0, 0, At8, B08); MM(0, 1, At8, B18); PG8_SCHED; PG8_BAR; PG8_SCHED; \
            PG8_LDA8(At8, 0, 1); PG8_STAGE(PG8_SB(0, 0), b2, voffB); PG8_STAGE(PG8_SB(0, 1), b2 + hstepB, voffB); PG8_STAGE(PG8_SA(0, 0), a2, w0); \
            PG8_WAIT_V(8); PG8_WAIT_L(0); PG8_BAR; PG8_SCHED; MM(1, 0, At8, B08); MM(1, 1, At8, B18); PG8_SCHED; PG8_BAR; PG8_SCHED; \
            PG8_LDB8(B08, 1, 0); PG8_LDB8(B18, 1, 1); PG8_SCHED; PG8_LDA8(At8, 1, 0); PG8_STAGE(PG8_SA(0, 1), a2, w1); \
            PG8_WAIT_V(8); PG8_WAIT_L(0); PG8_BAR; PG8_SCHED; PG8_MMA8(0, 0, At8, B08); PG8_MMA8(0, 1, At8, B18); PG8_SCHED; PG8_BAR; PG8_SCHED; \
            PG8_LDA8(At8, 1, 1); PG8_STAGE(PG8_SB(1, 0), b3, voffB); PG8_STAGE(PG8_SB(1, 1), b3 + hstepB, voffB); PG8_STAGE(PG8_SA(1, 0), a3, w0); \
            PG8_WAIT_V(8); PG8_WAIT_L(0); PG8_BAR; PG8_SCHED; PG8_MMA8(1, 0, At8, B08); PG8_MMA8(1, 1, At8, B18); PG8_SCHED; PG8_BAR; PG8_SCHED;
        if constexpr (MODE != 2) {
            const char* a1 = cA + kstep; const char* a2 = cA + 2 * kstep; const char* b2 = cB + 2 * kstep; const char* a3 = a2 + kstep; const char* b3 = b2 + kstep;
            unsigned w0[2], w1[2]; w0[0] = vc[0][0]; w0[1] = vc[0][1]; w1[0] = vc[1][0]; w1[1] = vc[1][1];
            if constexpr (!FP8) { PG8_BODY0(PG8_MMAZ) } else { PG8_BODY1(PG8_MMA8Z) }
        }
        for (int t = (MODE == 2) ? 0 : 2; t < nt; t += 2) {
            const bool last = (t == nt - 2);
            const char* a1 = cA + (size_t)(t + 1) * kstep;
            const char* a2 = last ? cA : cA + (size_t)(t + 2) * kstep; const char* b2 = last ? nB : cB + (size_t)(t + 2) * kstep;
            const char* a3 = a2 + kstep; const char* b3 = b2 + kstep;
            unsigned w0[2], w1[2];
            w0[0] = last ? vn[0][0] : vc[0][0]; w0[1] = last ? vn[0][1] : vc[0][1]; w1[0] = last ? vn[1][0] : vc[1][0]; w1[1] = last ? vn[1][1] : vc[1][1];
            if constexpr (MODE == 2) {
            const bool first = t < (nt >> 1);
            PG8_LDB(B0, 0, 0); PG8_SCHED; PG8_LDA(At, 0, 0); PG8_STAGE(PG8_SA(1, 1), a1, vc[1]);
            PG8_WAIT_V(6); PG8_WAIT_L(0); PG8_BAR; if (first) { PG8_MMA(0, 0, At, B0); } else { PG8_MMA(0, 1, At, B0); } PG8_BAR; PG8_SCHED;
            PG8_LDA(At, 0, 1); PG8_STAGE(PG8_SB(0, 0), b2, voffB); PG8_STAGE(PG8_SA(0, 0), a2, w0);
            PG8_WAIT_V(6); PG8_WAIT_L(0); PG8_BAR; if (first) { PG8_MMA(1, 0, At, B0); } else { PG8_MMA(1, 1, At, B0); } PG8_BAR; PG8_SCHED;
            PG8_LDB(B0, 1, 0); PG8_SCHED; PG8_LDA(At, 1, 0); PG8_STAGE(PG8_SA(0, 1), a2, w1);
            PG8_WAIT_V(6); PG8_WAIT_L(0); PG8_BAR; if (first) { PG8_MMA(0, 0, At, B0); } else { PG8_MMA(0, 1, At, B0); } PG8_BAR; PG8_SCHED;
            PG8_LDA(At, 1, 1); PG8_STAGE(PG8_SB(1, 0), b3, voffB); PG8_STAGE(PG8_SA(1, 0), a3, w0);
            PG8_WAIT_V(6); PG8_WAIT_L(0); PG8_BAR; if (first) { PG8_MMA(1, 0, At, B0); } else { PG8_MMA(1, 1, At, B0); } PG8_BAR; PG8_SCHED;
            } else if constexpr (!FP8) { PG8_BODY0(PG8_MMA) } else { PG8_BODY1(PG8_MMA8) }
        }
#undef PG8_BODY0
#undef PG8_BODY1
        if (wr == 0) PG8_BAR;
        E(acc, cur, wr, wc, fr, fq, (const PG8_LAS float*)(lds + BIAS_LDS + (ui & 1) * 1024));
        if (!has_next) break;
        if constexpr (MODE == 2) {
#pragma unroll
        for (int a = 0; a < 2; ++a)
#pragma unroll
            for (int b = 0; b < 2; ++b)
#pragma unroll
                for (int m = 0; m < 4; ++m)
#pragma unroll
                    for (int n = 0; n < 2; ++n) acc[a][b][m][n] = (f32x4){0.f, 0.f, 0.f, 0.f};
        }
        prevrb2 = prevrb; prevrb = cur.x1 >> 8; cur = nxt; cB = nB; ++ui;
#pragma unroll
        for (int h = 0; h < 2; ++h)
#pragma unroll
            for (int i = 0; i < 2; ++i) vc[h][i] = vn[h][i];
        if (wr == 1) PG8_BAR;
    }
    PG8_WAIT_V(0);
    PG8_BAR;
    if constexpr (Sched::DFLOW == 1) { if (S.flags && wid == 0 && lane == 0) { __hip_atomic_fetch_add(S.flags + (cur.x1 >> 8), 1u, __ATOMIC_RELAXED, __HIP_MEMORY_SCOPE_AGENT);
        if (ui > 0) __hip_atomic_fetch_add(S.flags + prevrb, 1u, __ATOMIC_RELAXED, __HIP_MEMORY_SCOPE_AGENT); } }
#undef PG8_TOKSLOT
#undef PG8_SA
#undef PG8_SB
#undef PG8_STAGE
#undef PG8_LDA
#undef PG8_LDB
#undef PG8_MMA
#undef PG8_LDA8
#undef PG8_LDB8
#undef PG8_MMA8
#undef PG8_MMAZ
#undef PG8_MMA8Z
#undef PG8_WAIT_V
#undef PG8_WAIT_L
#undef PG8_BAR
#undef PG8_SCHED
}
}

namespace att {
#define ATT_LAS __attribute__((address_space(3)))
typedef unsigned short bf16_t;
typedef short bf16x8 __attribute__((ext_vector_type(8)));
typedef short s16x4 __attribute__((ext_vector_type(4)));
typedef float f32x16 __attribute__((ext_vector_type(16)));
typedef unsigned u32x4 __attribute__((ext_vector_type(4)));
constexpr int PITCH = 64, OPITCH = D, NSLOT = 3, GRPB = (NSLOT + 1) * 16384;
constexpr size_t KIND = (size_t)BATCH * 8 * SEQ * 64;
constexpr int LDS_RING = 0, LDS_WS = GRPB, LDS_TB = LDS_WS + 2048, TBS = 324, TB0 = 192, LDS_FLAG = LDS_TB + 8 * TBS * 4, LDS_GBAR = LDS_FLAG + 64, LDS_OST = LDS_GBAR + 64, LDS_END = LDS_OST + 4 * 4096;
constexpr float SB_EXIT = 1.17549435e-38f;
constexpr float CA_THR = 6.0f;
__device__ __forceinline__ int crow(int r, int hi) { return (r & 3) + 8 * (r >> 2) + 4 * hi; }
__device__ __forceinline__ unsigned cvtpk(float lo, float hi) { return pg8::cvt_pk_bf16(lo, hi); }
__device__ __forceinline__ s16x4 vtr(const ATT_LAS char* p) { typedef short v4i16_t __attribute__((ext_vector_type(4))); return __builtin_bit_cast(s16x4, __builtin_amdgcn_ds_read_tr16_b64_v4i16((ATT_LAS v4i16_t*)p)); }
__device__ __forceinline__ float xsum32(float v) { auto rr = __builtin_amdgcn_permlane32_swap(__float_as_uint(v), __float_as_uint(v), false, false); return __uint_as_float(rr[0]) + __uint_as_float(rr[1]); }
__device__ __forceinline__ float xmax32(float v) { auto rr = __builtin_amdgcn_permlane32_swap(__float_as_uint(v), __float_as_uint(v), false, false); return fmaxf(__uint_as_float(rr[0]), __uint_as_float(rr[1])); }
struct GBar { ATT_LAS unsigned* cnt; unsigned target; };
__device__ __forceinline__ void gbar_arrive_wait(GBar& b, int lane) {
    const unsigned a = (unsigned)(size_t)b.cnt;
    if (lane == 0) { const unsigned one = 1u; asm volatile("ds_add_u32 %0, %1" :: "v"(a), "v"(one) : "memory"); }
    b.target += 4u;
    for (;;) { unsigned v; asm volatile("ds_read_b32 %0, %1\n\ts_waitcnt lgkmcnt(0)" : "=v"(v) : "v"(a) : "memory"); if ((int)((unsigned)__builtin_amdgcn_readfirstlane(v) - b.target) >= 0) break; }
    asm volatile("" ::: "memory");
}
#define ATT_BAR() do { asm volatile("s_waitcnt vmcnt(0) lgkmcnt(0)" ::: "memory"); gbar_arrive_wait(gb, lane); } while (0)
#define ATT_BAR8() do { asm volatile("s_waitcnt vmcnt(8) lgkmcnt(0)" ::: "memory"); gbar_arrive_wait(gb, lane); } while (0)
#define ATT_BAR4() do { asm volatile("s_waitcnt vmcnt(4) lgkmcnt(0)" ::: "memory"); gbar_arrive_wait(gb, lane); } while (0)

__device__ __forceinline__ void dma_tile(ATT_LAS char* dst, const bf16_t* Kb, const bf16_t* Vb, int k0, int g, int lane) {
#pragma unroll
    for (int j = 0; j < 2; ++j) { const int i = 2 * g + j; const int row = 8 * i + (lane >> 3); const int ch = (lane & 7) ^ ((row >> 1) & 7);
        __builtin_amdgcn_global_load_lds((const unsigned*)(Kb + (size_t)(k0 + row) * PITCH + ch * 8), (ATT_LAS unsigned*)(dst + i * 1024), 16, 0, 0); }
#pragma unroll
    for (int j = 0; j < 2; ++j) { const int i = 2 * g + j;
        __builtin_amdgcn_global_load_lds((const unsigned*)(Vb + (size_t)(k0 + 16 * (i & 3) + (lane >> 2)) * PITCH + (i >> 2) * 32 + (lane & 3) * 8), (ATT_LAS unsigned*)(dst + 8192 + i * 1024), 16, 0, 0); }
}
__device__ __forceinline__ void qkt(f32x16& p0, f32x16& p1, const ATT_LAS char* kb, int lane, const bf16x8 (&qr)[4]) {
    const int r32 = lane & 31, hi = lane >> 5, xr = (r32 >> 1) & 7;
    const f32x16 z = {0.f, 0.f, 0.f, 0.f, 0.f, 0.f, 0.f, 0.f, 0.f, 0.f, 0.f, 0.f, 0.f, 0.f, 0.f, 0.f};
    bf16x8 kf[8];
#pragma unroll
    for (int d0 = 0; d0 < 4; ++d0) { const ATT_LAS char* p = kb + r32 * 128 + (((2 * d0 + hi) ^ xr) * 16); kf[2 * d0] = *(const ATT_LAS bf16x8*)p; kf[2 * d0 + 1] = *(const ATT_LAS bf16x8*)(p + 4096); }
    p0 = __builtin_amdgcn_mfma_f32_32x32x16_bf16(kf[0], qr[0], z, 0, 0, 0); p1 = __builtin_amdgcn_mfma_f32_32x32x16_bf16(kf[1], qr[0], z, 0, 0, 0);
#pragma unroll
    for (int d0 = 1; d0 < 4; ++d0) { p0 = __builtin_amdgcn_mfma_f32_32x32x16_bf16(kf[2 * d0], qr[d0], p0, 0, 0, 0); p1 = __builtin_amdgcn_mfma_f32_32x32x16_bf16(kf[2 * d0 + 1], qr[d0], p1, 0, 0, 0); }
}
typedef int v2i_t __attribute__((ext_vector_type(2)));
#define ATT_VTR(dst, off) asm volatile("ds_read_b64_tr_b16 %0, %1 offset:" #off : "=v"(dst) : "v"(va) : "memory")
#define ATT_PV4(d0, O0, O1, O2, O3, O4, O5, O6, O7) do { v2i_t f0, f1, f2, f3, f4, f5, f6, f7; \
        ATT_VTR(f0, O0); ATT_VTR(f1, O1); ATT_VTR(f2, O2); ATT_VTR(f3, O3); ATT_VTR(f4, O4); ATT_VTR(f5, O5); ATT_VTR(f6, O6); ATT_VTR(f7, O7); \
        asm volatile("s_waitcnt lgkmcnt(0)" : "+v"(f0), "+v"(f1), "+v"(f2), "+v"(f3), "+v"(f4), "+v"(f5), "+v"(f6), "+v"(f7) :: "memory"); \
        o[d0] = __builtin_amdgcn_mfma_f32_32x32x16_bf16(pa[0], __builtin_bit_cast(bf16x8, (u32x4){(unsigned)f0.x, (unsigned)f0.y, (unsigned)f1.x, (unsigned)f1.y}), o[d0], 0, 0, 0); \
        o[d0] = __builtin_amdgcn_mfma_f32_32x32x16_bf16(pa[1], __builtin_bit_cast(bf16x8, (u32x4){(unsigned)f2.x, (unsigned)f2.y, (unsigned)f3.x, (unsigned)f3.y}), o[d0], 0, 0, 0); \
        o[d0] = __builtin_amdgcn_mfma_f32_32x32x16_bf16(pa[2], __builtin_bit_cast(bf16x8, (u32x4){(unsigned)f4.x, (unsigned)f4.y, (unsigned)f5.x, (unsigned)f5.y}), o[d0], 0, 0, 0); \
        o[d0] = __builtin_amdgcn_mfma_f32_32x32x16_bf16(pa[3], __builtin_bit_cast(bf16x8, (u32x4){(unsigned)f6.x, (unsigned)f6.y, (unsigned)f7.x, (unsigned)f7.y}), o[d0], 0, 0, 0); } while (0)
__device__ __forceinline__ void pv(f32x16 (&o)[2], const ATT_LAS char* vp, const f32x16& p0, const f32x16& p1) {
    bf16x8 pa[4];
#pragma unroll
    for (int ks = 0; ks < 4; ++ks) { u32x4 w;
#pragma unroll
        for (int j = 0; j < 4; ++j) { const int r = (ks & 1) * 8 + 2 * j; w[j] = (ks < 2) ? cvtpk(p0[r], p0[r + 1]) : cvtpk(p1[r], p1[r + 1]); }
        pa[ks] = __builtin_bit_cast(bf16x8, w); }
    const unsigned va = (unsigned)(size_t)vp;
    ATT_PV4(0, 0, 512, 1024, 1536, 2048, 2560, 3072, 3584);
    ATT_PV4(1, 4096, 4608, 5120, 5632, 6144, 6656, 7168, 7680);
}
struct OPend { bf16_t* dst; };
__device__ __forceinline__ void stage_o(ATT_LAS bf16_t* stg, const f32x16 (&o)[2], int lane) {
    const int r32 = lane & 31, hi = lane >> 5;
#pragma unroll
    for (int r = 0; r < 16; ++r)
#pragma unroll
        for (int d0 = 0; d0 < 2; ++d0) { const unsigned w = cvtpk(o[d0][r], 0.f); stg[crow(r, hi) * 64 + d0 * 32 + r32] = (bf16_t)(w & 0xffffu); }
}
__device__ __forceinline__ void flush_o(const ATT_LAS bf16_t* stg, OPend& p, int lane) {
    if (p.dst == nullptr) return;
#pragma unroll
    for (int i = 0; i < 4; ++i) { const int row = i * 8 + (lane >> 3), ch = lane & 7; const u32x4 v = *(const ATT_LAS u32x4*)(stg + row * 64 + ch * 8); *(u32x4*)(p.dst + (size_t)row * OPITCH + ch * 8) = v; }
    p.dst = nullptr;
}

__device__ __forceinline__ void sb_tile(f32x16& p0, f32x16& p1, float& carry, bool diag, int lim, int hi) {
    if (diag) {
#pragma unroll
        for (int r = 0; r < 16; ++r) { const int kv = crow(r, hi); if (kv >= lim) p0[r] = -1e30f; if (kv + 32 >= lim) p1[r] = -1e30f; } }
    f32x16 r0, r1;
#pragma unroll
    for (int r = 0; r < 16; ++r) { const float v0 = __builtin_amdgcn_exp2f(fminf(p0[r], 100.f)), v1 = __builtin_amdgcn_exp2f(fminf(p1[r], 100.f));
        r0[r] = __builtin_amdgcn_rcpf(1.0f + v0); r1[r] = __builtin_amdgcn_rcpf(1.0f + v1); p0[r] = v0 * r0[r]; p1[r] = v1 * r1[r]; }
    float ex[8]; float T = carry;
    { float qs[8], E[8], Od[8];
#pragma unroll
        for (int g = 0; g < 4; ++g) { qs[g] = (r0[4 * g] * r0[4 * g + 1]) * (r0[4 * g + 2] * r0[4 * g + 3]); qs[4 + g] = (r1[4 * g] * r1[4 * g + 1]) * (r1[4 * g + 2] * r1[4 * g + 3]); }
#pragma unroll
        for (int g = 0; g < 8; ++g) { auto rr = __builtin_amdgcn_permlane32_swap(__float_as_uint(qs[g]), __float_as_uint(qs[g]), false, false); E[g] = __uint_as_float(rr[0]); Od[g] = __uint_as_float(rr[1]); }
#pragma unroll
        for (int g = 7; g >= 0; --g) { const float exO = T; T *= Od[g]; const float exE = T; T *= E[g]; ex[g] = hi ? exO : exE; } }
    carry = T;
#pragma unroll
    for (int g = 0; g < 4; ++g) {
        float f = ex[g];
#pragma unroll
        for (int i = 3; i >= 0; --i) { p0[4 * g + i] *= f; f *= r0[4 * g + i]; }
        f = ex[4 + g];
#pragma unroll
        for (int i = 3; i >= 0; --i) { p1[4 * g + i] *= f; f *= r1[4 * g + i]; }
    }
}

__device__ __forceinline__ int att_unit(int amap, int vcu, int G, int ui) {
    if (amap < 0) return vcu + G * ui;
    const int x = amap >> 5, j = (amap & 31) + 32 * ui;
    return ((((x >> 1) * 8) + (j >> 4)) << 5) | (16 * (x & 1) + (j & 15));
}
__device__ __forceinline__ void sb_stream(const bf16_t* QKVG, bf16_t* O, ATT_LAS char* lds, int wave, int lane, GBar& gb, OPend& op, int vcu, int G, int amap) {
    const int g = wave & 3, r32 = lane & 31, hi = lane >> 5;
    const int nu = (amap >= 0) ? 4 : ((vcu < BATCH * 8 * 32) ? (BATCH * 8 * 32 - vcu + G - 1) / G : 0);
    if (nu == 0) return;
    ATT_LAS char* ring = lds + LDS_RING;
    ATT_LAS unsigned* flag = (ATT_LAS unsigned*)(lds + LDS_FLAG);
    ATT_LAS bf16_t* stg = (ATT_LAS bf16_t*)(lds + LDS_OST + wave * 4096);
    const int vpo = 8192 + ((lane >> 4) & 1) * 32 + (lane & 3) * 8 + (4 * hi + ((lane & 15) >> 2)) * 64;
    int b, h, cp, cw, q0, kt_hi; const bf16_t* Kb; const bf16_t* Vb; bf16x8 qr[4];
#define SB_SETUP(ui) do { const int u_ = att_unit(amap, vcu, G, (ui)), bh_ = u_ >> 5; cp = u_ & 31; b = bh_ >> 3; h = bh_ & 7; cw = 2 * cp + (g >> 1); q0 = cw * 64 + (g & 1) * 32; kt_hi = 2 * cp + 1; \
        const size_t hb_ = (size_t)bh_ * SEQ * 64; Kb = QKVG + 1 * KIND + hb_; Vb = QKVG + 2 * KIND + hb_; const bf16_t* q_ = QKVG + 0 * KIND + hb_ + (size_t)(q0 + r32) * 64; \
        dma_tile(ring, Kb, Vb, kt_hi * 64, g, lane); dma_tile(ring + 16384, Kb, Vb, (kt_hi - 1) * 64, g, lane);        \
        _Pragma("unroll") for (int d0 = 0; d0 < 4; ++d0) qr[d0] = *(const bf16x8*)(q_ + d0 * 16 + hi * 8); \
        asm volatile("" : "+v"(qr[0]), "+v"(qr[1]), "+v"(qr[2]), "+v"(qr[3]) :: "memory"); } while (0)
    ATT_BAR();
    flush_o(stg, op, lane); asm volatile("" ::: "memory");
    SB_SETUP(0);
    for (int ui = 0; ui < nu; ++ui) {
        f32x16 o[2]; o[0] = (f32x16){0.f, 0.f, 0.f, 0.f, 0.f, 0.f, 0.f, 0.f, 0.f, 0.f, 0.f, 0.f, 0.f, 0.f, 0.f, 0.f}; o[1] = o[0];
        float carry = 1.0f; bool done = false, ahead = true; int sl = 0;
        for (int it = 0;; ++it) {
            const int kt = kt_hi - it;
            if (ahead) ATT_BAR4(); else ATT_BAR();
            if (it > 0) { const ATT_LAS unsigned* f = flag + ((it - 1) & 1) * 4; const unsigned a = f[0] & f[1] & f[2] & f[3];
                if (__builtin_amdgcn_readfirstlane(a)) break; }
            flush_o(stg, op, lane); asm volatile("" ::: "memory");
            const int sl2 = (sl >= 1) ? sl - 1 : 2;
            const bool issue = ahead && (kt >= 2);
            if (issue) dma_tile(ring + sl2 * 16384, Kb, Vb, (kt - 2) * 64, g, lane);
            if (!done && kt <= cw) {
                const ATT_LAS char* slot = ring + sl * 16384;
                f32x16 p0, p1; qkt(p0, p1, slot, lane, qr);
                sb_tile(p0, p1, carry, kt == cw, q0 - kt * 64 + r32, hi);
                pv(o, slot + vpo, p0, p1);
                done = (kt == 0) || __all(carry < SB_EXIT);
            }
            if (lane == 0) flag[(it & 1) * 4 + g] = done ? 1u : 0u;
            ahead = issue; sl = (sl == 2) ? 0 : sl + 1;
        }
        bf16_t* odst = O + ((size_t)b * SEQ + q0) * OPITCH + h * 64;
        if (ui + 1 < nu) SB_SETUP(ui + 1);
        stage_o(stg, o, lane); op.dst = odst;
    }
    asm volatile("s_waitcnt vmcnt(0)" ::: "memory");
#undef SB_SETUP
}

__device__ __forceinline__ void ca_stream(const bf16_t* QKVG, bf16_t* O, ATT_LAS char* lds, int wave, int lane, GBar& gb, OPend& op, int vcu, int G, int amap) {
    const int g = wave & 3, r32 = lane & 31, hi = lane >> 5;
    const int nu = (amap >= 0) ? 4 : ((vcu < BATCH * 8 * 32) ? (BATCH * 8 * 32 - vcu + G - 1) / G : 0);
    if (nu == 0) return;
    ATT_LAS char* ring = lds + LDS_RING;
    ATT_LAS float* wsf = (ATT_LAS float*)(lds + LDS_WS + wave * 256);
    ATT_LAS bf16_t* stg = (ATT_LAS bf16_t*)(lds + LDS_OST + wave * 4096);
    const int vpo = 8192 + ((lane >> 4) & 1) * 32 + (lane & 3) * 8 + (4 * hi + ((lane & 15) >> 2)) * 64;
    int d_ui = 0, d_kc, d_hi, d_sl = 0, issued = 0; const bf16_t* d_K; const bf16_t* d_V; bool d_valid = true;
#define CA_SETUP_D(ui) do { const int u_ = att_unit(amap, vcu, G, (ui)), bh_ = u_ >> 5, cp_ = u_ & 31; const size_t hb_ = (size_t)bh_ * SEQ * 64; d_K = QKVG + 4 * KIND + hb_; d_V = QKVG + 5 * KIND + hb_; d_kc = (2 * cp_ >= 8) ? 2 * cp_ - 8 : 0; d_hi = 2 * cp_ + 1; } while (0)
#define CA_LOADQ(dst, ui) do { const int u_ = att_unit(amap, vcu, G, (ui)), bh_ = u_ >> 5, cp_ = u_ & 31; const bf16_t* q_ = QKVG + 3 * KIND + (size_t)bh_ * SEQ * 64 + (size_t)((2 * cp_ + (g >> 1)) * 64 + (g & 1) * 32 + r32) * 64; \
        _Pragma("unroll") for (int d0 = 0; d0 < 4; ++d0) dst[d0] = *(const bf16x8*)(q_ + d0 * 16 + hi * 8); } while (0)
#define CA_ISSUE() do { if (d_valid) { \
        dma_tile(ring + d_sl * 16384, d_K, d_V, d_kc * 64, g, lane); ++issued; d_sl = (d_sl + 1) & 3; \
        if (d_kc == d_hi) { ++d_ui; if (d_ui < nu) CA_SETUP_D(d_ui); else d_valid = false; } else ++d_kc; } } while (0)
    bf16x8 qr[4], qn[4];
    CA_SETUP_D(0);
    CA_LOADQ(qr, 0);
#pragma unroll
    for (int d0 = 0; d0 < 4; ++d0) qn[d0] = qr[d0];
    ATT_BAR();
    flush_o(stg, op, lane); asm volatile("" ::: "memory");
    CA_ISSUE(); CA_ISSUE(); CA_ISSUE();
    int c_ui = 0, T = 0, slc = 0;
    int cp, b, h, cw, q0, kc, kc_hi; const ATT_LAS float* tbh; float bfar;
#define CA_SETUP_C(ui) do { const int u_ = att_unit(amap, vcu, G, (ui)), bh_ = u_ >> 5; cp = u_ & 31; b = bh_ >> 3; h = bh_ & 7; cw = 2 * cp + (g >> 1); q0 = cw * 64 + (g & 1) * 32; kc = (2 * cp >= 8) ? 2 * cp - 8 : 0; kc_hi = 2 * cp + 1; \
        tbh = (const ATT_LAS float*)(lds + LDS_TB) + h * TBS; bfar = tbh[512 - TB0]; } while (0)
    CA_SETUP_C(0);
    f32x16 o[2]; o[0] = (f32x16){0.f, 0.f, 0.f, 0.f, 0.f, 0.f, 0.f, 0.f, 0.f, 0.f, 0.f, 0.f, 0.f, 0.f, 0.f, 0.f}; o[1] = o[0];
    float m_run = -1e30f, l = 0.f;
    for (;;) {
        if (issued > T + 2) ATT_BAR8(); else if (issued > T + 1) ATT_BAR4(); else ATT_BAR();
        flush_o(stg, op, lane);
        if (kc == kc_hi - 1 && c_ui + 1 < nu) CA_LOADQ(qn, c_ui + 1);
        asm volatile("" ::: "memory");
        CA_ISSUE();
        if (kc + 8 >= cw && kc <= cw) {
            const ATT_LAS char* slot = ring + slc * 16384;
            f32x16 p0, p1; qkt(p0, p1, slot, lane, qr);
            const int dl = q0 + r32 - kc * 64 - 4 * hi;
            if (cw - kc >= 5) {
#pragma unroll
                for (int r = 0; r < 16; ++r) { p0[r] += bfar; p1[r] += bfar; }
            } else if (cw - kc == 4) {
#pragma unroll
                for (int r = 0; r < 16; ++r) { const int cr = (r & 3) + 8 * (r >> 2); int i0 = dl - cr, i1 = dl - cr - 32; i0 = (i0 > 256 ? 256 : i0) + (256 - TB0); i1 = (i1 > 256 ? 256 : i1) + (256 - TB0);
                    p0[r] += tbh[i0]; p1[r] += tbh[i1]; }
            } else {
                const ATT_LAS float* tb0 = tbh + (dl + (256 - TB0));
#pragma unroll
                for (int r = 0; r < 16; ++r) { const int cr = (r & 3) + 8 * (r >> 2); p0[r] += tb0[-cr]; p1[r] += tb0[-cr - 32]; }
            }
            float mt = fmaxf(p0[0], p1[0]);
#pragma unroll
            for (int r = 1; r < 16; ++r) mt = fmaxf(mt, fmaxf(p0[r], p1[r]));
            mt = xmax32(mt);
            if (__any(mt > m_run + CA_THR)) {
                const float m_new = (mt > m_run + CA_THR) ? mt : m_run; const float alpha = __builtin_amdgcn_exp2f(m_run - m_new); m_run = m_new; l *= alpha;
                if (hi == 0) wsf[r32] = alpha;
                asm volatile("" ::: "memory");
#pragma unroll
                for (int r = 0; r < 16; ++r) { const float a = wsf[crow(r, hi)]; o[0][r] *= a; o[1][r] *= a; }
                asm volatile("" ::: "memory");
            }
            float ls = 0.f;
#pragma unroll
            for (int r = 0; r < 16; ++r) { p0[r] = __builtin_amdgcn_exp2f(p0[r] - m_run); p1[r] = __builtin_amdgcn_exp2f(p1[r] - m_run); ls += p0[r] + p1[r]; }
            l += ls;
            pv(o, slot + vpo, p0, p1);
        }
        ++T; slc = (slc + 1) & 3;
        if (kc == kc_hi) {
            l = xsum32(l);
            if (hi == 0) wsf[r32] = __builtin_amdgcn_rcpf(l);
            asm volatile("" ::: "memory");
#pragma unroll
            for (int r = 0; r < 16; ++r) { const float a = wsf[crow(r, hi)]; o[0][r] *= a; o[1][r] *= a; }
            asm volatile("" ::: "memory");
            stage_o(stg, o, lane); op.dst = O + ((size_t)b * SEQ + q0) * OPITCH + 512 + h * 64;
            ++c_ui; if (c_ui == nu) break;
            CA_SETUP_C(c_ui);
#pragma unroll
            for (int d0 = 0; d0 < 4; ++d0) qr[d0] = qn[d0];
            o[0] = (f32x16){0.f, 0.f, 0.f, 0.f, 0.f, 0.f, 0.f, 0.f, 0.f, 0.f, 0.f, 0.f, 0.f, 0.f, 0.f, 0.f}; o[1] = o[0]; m_run = -1e30f; l = 0.f;
        } else ++kc;
    }
    asm volatile("s_waitcnt vmcnt(0)" ::: "memory");
#undef CA_SETUP_D
#undef CA_LOADQ
#undef CA_ISSUE
#undef CA_SETUP_C
}
}

constexpr int NWAVES = 8;
constexpr int N_PHASES = 10;
constexpr int N_LAUNCHES = MK_N_LAUNCHES;
static_assert(N_LAUNCHES == 1 || N_LAUNCHES == N_PHASES, "MK_N_LAUNCHES is 1 or 10");
static_assert(att::LDS_END <= 96256 && 96256 + 4 * 16640 <= 162816, "attention + conversion LDS regions");

constexpr size_t MiB = 1u << 20;
constexpr int CVT_NE = 26, CVT_NO = 48 - CVT_NE, CVT_SE = 40, CVT_SO = 72;
constexpr int RBFLAG_W = 12288;
constexpr size_t WS_CTL = 0, CTL_ZERO_BYTES = 64 * 1024;
constexpr size_t WS_MOD = 1 * MiB;
constexpr size_t WS_WCAT = 2 * MiB;
constexpr size_t WS_WBR = 12 * MiB;
constexpr size_t WS_WOUT = 14 * MiB;
constexpr size_t WS_W1T = 16 * MiB;
constexpr size_t WS_H8 = 80 * MiB;
constexpr size_t WS_WG8 = 96 * MiB;
constexpr size_t WS_W2T = 144 * MiB;
constexpr size_t WS_H = 208 * MiB;
constexpr size_t WS_QKVG = 240 * MiB;
constexpr size_t WS_O = 400 * MiB;
constexpr size_t WS_TMP = 432 * MiB;
constexpr size_t WS_MIXIN = 496 * MiB;
constexpr size_t WS_MIXED = 528 * MiB;
constexpr size_t WS_H2 = 560 * MiB;
constexpr size_t WS_HID = 592 * MiB;
constexpr size_t WS_Y = 736 * MiB;
constexpr size_t WS_ROWTOK = 880 * MiB;
constexpr size_t WS_SLOT = 882 * MiB;
constexpr size_t WS_END = 884 * MiB;
constexpr int CW_CNT = 1024;
constexpr int CW_BAR = 4096;

constexpr int RING_BYTES = 131072;
constexpr int LDSCTL_OFF = 162816;
constexpr int LDS_BYTES = 163840;
constexpr int MOETAB_OFF = LDSCTL_OFF + 64;

#define GAS __attribute__((address_space(1)))
#define LAS __attribute__((address_space(3)))
typedef unsigned short bf16;
typedef unsigned v4u __attribute__((ext_vector_type(4)));
typedef unsigned v2u __attribute__((ext_vector_type(2)));
typedef float f32x4 __attribute__((ext_vector_type(4)));
typedef GAS unsigned gu32;
#define RLX_AGENT __ATOMIC_RELAXED, __HIP_MEMORY_SCOPE_AGENT
#define LDS_WAIT() asm volatile("s_waitcnt lgkmcnt(0)" ::: "memory")
#define VM_WAIT() asm volatile("s_waitcnt vmcnt(0)" ::: "memory")

#define XB_TMO      128
#define XB_XCNT(j)  (256  + 64 * (j))
#define XB_XSUB(j)  (1280 + 64 * (j))
#define XB_XGEN(j)  (2304 + 64 * (j))
#define XB_TOP      3328
#define XB_TOPGEN   3392
#define XCD_BAR_WORDS 3456
#define XB_SPIN_CAP (1u << 18)
__device__ __forceinline__ unsigned xb_ld(unsigned* p)              { return __hip_atomic_load(p, __ATOMIC_RELAXED, __HIP_MEMORY_SCOPE_AGENT); }
__device__ __forceinline__ unsigned xb_add(unsigned* p, unsigned v) { return __hip_atomic_fetch_add(p, v, __ATOMIC_RELAXED, __HIP_MEMORY_SCOPE_AGENT); }
__device__ __forceinline__ unsigned xb_xcc_id() { return (unsigned)__builtin_amdgcn_s_getreg((3 << 11) | 20) & 0xFu; }
#define XB_SPIN(cond, bar) do { unsigned _sp = 0; while (cond) { __builtin_amdgcn_s_sleep(1); \
    if ((++_sp & 255u) == 0u) { if (xb_ld(&(bar)[XB_TMO])) break; if (_sp > XB_SPIN_CAP) { atomicAdd(&(bar)[XB_TMO], 1u); break; } } } } while (0)
struct XcdBarrier { unsigned* bar; unsigned x; volatile LAS unsigned* st; };
__device__ __forceinline__ XcdBarrier xcd_barrier_post(unsigned* bar, volatile LAS unsigned* st) {
    XcdBarrier b; b.bar = bar; b.x = xb_xcc_id(); b.st = st;
    if (threadIdx.x == 0) st[3] = xb_add(&bar[XB_XCNT(b.x)], 1u);
    return b;
}
__device__ __forceinline__ void xcd_barrier_complete(unsigned* bar, unsigned x, unsigned& nloc, unsigned& nx, unsigned& uni) {
    const unsigned G = gridDim.x * gridDim.y * gridDim.z;
    unsigned sum, cnt, mine, sp = 0u, bad;
    for (;;) {
        sum = 0u; cnt = 0u; mine = 0u; bad = 0u;
#pragma unroll
        for (unsigned j = 0; j < 16; ++j) { const unsigned c = xb_ld(&bar[XB_XCNT(j)]); sum += c; cnt += (c > 0u) ? 1u : 0u; mine = (j == x) ? c : mine; bad |= (j < 8u) ? ((c * 8u != G) ? 1u : 0u) : ((c != 0u) ? 1u : 0u); }
        if (sum == G) break;
        __builtin_amdgcn_s_sleep(1);
        if ((++sp & 255u) == 0u) { if (xb_ld(&bar[XB_TMO])) break; if (sp > XB_SPIN_CAP) { atomicAdd(&bar[XB_TMO], 1u); break; } }
    }
    nloc = mine > 0u ? mine : 1u; nx = cnt > 0u ? cnt : 1u; uni = (sum == G && bad == 0u) ? 1u : 0u;
}
__device__ __forceinline__ void xcd_barrier(const XcdBarrier& b) {
    asm volatile("s_waitcnt vmcnt(0)" ::: "memory");
    __syncthreads();
    if (threadIdx.x == 0) {
        unsigned* bar = b.bar;
        __builtin_amdgcn_s_waitcnt(0);
        unsigned nloc = b.st[0], nx = b.st[1];
        if (nloc == 0u) { unsigned uni; xcd_barrier_complete(bar, b.x, nloc, nx, uni); b.st[0] = nloc; b.st[1] = nx; b.st[2] = uni; }
        const unsigned old = xb_add(&bar[XB_XSUB(b.x)], 1u);
        const unsigned gen = old / nloc;
        if (old + 1u == (gen + 1u) * nloc) {
            __builtin_amdgcn_fence(__ATOMIC_RELEASE, "agent");
            asm volatile("s_waitcnt vmcnt(0)" ::: "memory");
            const unsigned og = xb_add(&bar[XB_TOP], 1u);
            const unsigned tg = og / nx;
            if (og + 1u == (tg + 1u) * nx) xb_add(&bar[XB_TOPGEN], 1u);
            else XB_SPIN(xb_ld(&bar[XB_TOPGEN]) == tg, bar);
            __builtin_amdgcn_fence(__ATOMIC_ACQUIRE, "agent");
            xb_add(&bar[XB_XGEN(b.x)], 1u);
            asm volatile("s_waitcnt vmcnt(0)" ::: "memory");
        } else {
            XB_SPIN(xb_ld(&bar[XB_XGEN(b.x)]) == gen, bar);
            __builtin_amdgcn_fence(__ATOMIC_ACQUIRE, "agent");
            asm volatile("s_waitcnt vmcnt(0)" ::: "memory");
        }
    }
    __syncthreads();
}

#define XB_LSUB(j)  (3520 + 64 * (j))
#define XB_LGEN(j)  (4608 + 64 * (j))
__device__ __forceinline__ void xcd_local_barrier(const XcdBarrier& b) {
    asm volatile("s_waitcnt vmcnt(0)" ::: "memory");
    __syncthreads();
    if (threadIdx.x == 0) {
        unsigned* bar = b.bar; const unsigned nloc = b.st[0];
        const unsigned old = xb_add(&bar[XB_LSUB(b.x)], 1u);
        const unsigned gen = old / nloc;
        if (old + 1u == (gen + 1u) * nloc) xb_add(&bar[XB_LGEN(b.x)], 1u);
        else XB_SPIN(xb_ld(&bar[XB_LGEN(b.x)]) == gen, bar);
        __builtin_amdgcn_fence(__ATOMIC_ACQUIRE, "agent");
        asm volatile("s_waitcnt vmcnt(0)" ::: "memory");
    }
    __syncthreads();
}

__device__ __forceinline__ float wave_sum(float v) {
#pragma unroll
    for (int o = 1; o < 64; o <<= 1) v += __shfl_xor(v, o);
    return v;
}
__device__ __forceinline__ unsigned pk2(float lo, float hi) { return pg8::cvt_pk_bf16(lo, hi); }
template <int CTL> __device__ __forceinline__ float dppf(float v) { return __int_as_float(__builtin_amdgcn_mov_dpp(__float_as_int(v), CTL, 0xF, 0xF, true)); }
__device__ __forceinline__ float sum16x(float v) { auto r = __builtin_amdgcn_permlane16_swap(__float_as_uint(v), __float_as_uint(v), false, false); return __uint_as_float(r[0]) + __uint_as_float(r[1]); }
__device__ __forceinline__ float sum32x(float v) { auto r = __builtin_amdgcn_permlane32_swap(__float_as_uint(v), __float_as_uint(v), false, false); return __uint_as_float(r[0]) + __uint_as_float(r[1]); }
__device__ __forceinline__ float wave_sum_fast(float v) {
    v += dppf<0xB1>(v); v += dppf<0x4E>(v); v += dppf<0x141>(v); v += dppf<0x140>(v); v = sum16x(v); return sum32x(v);
}

struct Args { const float* in[21]; float* out; unsigned char* ws; int ph_lo, ph_hi, li, pad; };

__device__ __forceinline__ void cvt_block(const float* W, int N, int k0, int n0, bf16* WT, int ldk, int drow0, int kd0, LAS float* scr, int lane) {
    const int c4 = 4 * (lane & 15), rq = lane >> 4;
    f32x4 v[16];
#pragma unroll
    for (int i = 0; i < 16; ++i) v[i] = __builtin_nontemporal_load((const GAS f32x4*)(W + (size_t)(k0 + rq + 4 * i) * N + n0 + c4));
#pragma unroll
    for (int i = 0; i < 16; ++i) { LAS float* s = scr + (rq + 4 * i) * 65 + c4; s[0] = v[i].x; s[1] = v[i].y; s[2] = v[i].z; s[3] = v[i].w; }
    LDS_WAIT(); asm volatile("" ::: "memory");
    const int c8 = lane & 7;
#pragma unroll
    for (int j = 0; j < 8; ++j) { const int n = (lane >> 3) + 8 * j; const LAS float* s = scr + (8 * c8) * 65 + n;
        v4u o; o.x = pk2(s[0 * 65], s[1 * 65]); o.y = pk2(s[2 * 65], s[3 * 65]); o.z = pk2(s[4 * 65], s[5 * 65]); o.w = pk2(s[6 * 65], s[7 * 65]);
        *(GAS v4u*)(WT + (size_t)(drow0 + n) * ldk + kd0 + k0 + 8 * c8) = o; }
    LDS_WAIT(); asm volatile("" ::: "memory");
}

__device__ __forceinline__ void cvt_block8(const float* W, int N, int k0, int n0, unsigned char* WT, int ldk, int drow0, LAS float* scr, int lane) {
    const int c4 = 4 * (lane & 15), rq = lane >> 4;
    f32x4 v[16];
#pragma unroll
    for (int i = 0; i < 16; ++i) v[i] = __builtin_nontemporal_load((const GAS f32x4*)(W + (size_t)(k0 + rq + 4 * i) * N + n0 + c4));
#pragma unroll
    for (int i = 0; i < 16; ++i) { LAS float* s = scr + (rq + 4 * i) * 65 + c4; s[0] = v[i].x * pg8::W8_SCALE; s[1] = v[i].y * pg8::W8_SCALE; s[2] = v[i].z * pg8::W8_SCALE; s[3] = v[i].w * pg8::W8_SCALE; }
    LDS_WAIT(); asm volatile("" ::: "memory");
    const int c8 = lane & 7;
#pragma unroll
    for (int j = 0; j < 8; ++j) { const int n = (lane >> 3) + 8 * j; const LAS float* s = scr + (8 * c8) * 65 + n;
        v2u o; o.x = pg8::cvt4_fp8(s[0 * 65], s[1 * 65], s[2 * 65], s[3 * 65]); o.y = pg8::cvt4_fp8(s[4 * 65], s[5 * 65], s[6 * 65], s[7 * 65]);
        __builtin_nontemporal_store(o, (GAS v2u*)(WT + (size_t)(drow0 + n) * ldk + k0 + 8 * c8)); }
    LDS_WAIT(); asm volatile("" ::: "memory");
}

__global__ void __launch_bounds__(NWAVES * 64, 2) mk_fwd(Args args) {
    extern __shared__ __attribute__((aligned(16))) unsigned char lds[];
    LAS unsigned char* L = (LAS unsigned char*)lds;
    const int tid0 = threadIdx.x, wave = __builtin_amdgcn_readfirstlane(tid0 >> 6);
    const int G = gridDim.x, bx = blockIdx.x;
    const int vcu = (G % 8 == 0) ? (bx % 8) * (G / 8) + bx / 8 : bx;
#define PHASE_PTRS() \
    int tid = tid0; asm volatile("" : "+v"(tid)); const int lane = tid & 63; (void)lane; \
    const __attribute__((address_space(4))) Args* ap_ = (const __attribute__((address_space(4))) Args*)__builtin_amdgcn_kernarg_segment_ptr(); asm volatile("" : "+s"(ap_)); \
    unsigned char* ws = ap_->ws; gu32* ctl = (gu32*)(ws + WS_CTL); \
    const float* x = ap_->in[0]; const float* cvec = ap_->in[1]; const float* w_ada = ap_->in[2]; const float* b_ada = ap_->in[3]; \
    const float* g_pre_mix = ap_->in[4]; const float* g_post_mix = ap_->in[5]; const float* w_in = ap_->in[6]; const float* rel_bias = ap_->in[7]; \
    const float* w_br_sb = ap_->in[8]; const float* w_br_ca = ap_->in[9]; const float* w_gate = ap_->in[10]; const float* b_gate = ap_->in[11]; \
    const float* w_out = ap_->in[12]; const float* g_pre_ffn = ap_->in[13]; const float* g_post_ffn = ap_->in[14]; const float* w_router = ap_->in[15]; \
    const float* b_router = ap_->in[16]; const float* w_e1 = ap_->in[17]; const float* b_e1 = ap_->in[18]; const float* w_e2 = ap_->in[19]; const float* b_e2 = ap_->in[20]; \
    float* out = ap_->out; float* MOD = (float*)(ws + WS_MOD); \
    bf16* WCAT = (bf16*)(ws + WS_WCAT); bf16* WBR = (bf16*)(ws + WS_WBR); bf16* WOUT = (bf16*)(ws + WS_WOUT); bf16* W1T = (bf16*)(ws + WS_W1T); bf16* W2T = (bf16*)(ws + WS_W2T); \
    bf16* Hb = (bf16*)(ws + WS_H); unsigned char* H8 = ws + WS_H8; unsigned char* WG8 = ws + WS_WG8; (void)H8; (void)WG8; bf16* QKVG = (bf16*)(ws + WS_QKVG); bf16* GATES = (bf16*)(ws + WS_QKVG + 96 * MiB); bf16* Ob = (bf16*)(ws + WS_O); float* TMP = (float*)(ws + WS_TMP); bf16* X1 = (bf16*)(ws + WS_TMP + 32 * MiB); (void)X1; \
    bf16* MIXIN = (bf16*)(ws + WS_MIXIN); bf16* MIXED = (bf16*)(ws + WS_MIXED); bf16* H2 = (bf16*)(ws + WS_H2); bf16* HID = (bf16*)(ws + WS_HID); bf16* Yb = (bf16*)(ws + WS_Y); \
    int* ROWTOK = (int*)(ws + WS_ROWTOK); v2u* SLOT = (v2u*)(ws + WS_SLOT); unsigned* gcnt = (unsigned*)(ctl + CW_CNT); \
    const bool probe = ap_->li != 0; \
    float* x1o = probe ? TMP : out; bf16* h2o = probe ? MIXIN : H2; int* rowtok_o = probe ? (int*)HID : ROWTOK; v2u* slot_o = probe ? (v2u*)(HID + 8 * MiB) : SLOT; unsigned* gcnt_o = probe ? gcnt + 32 : gcnt; \
    (void)x; (void)cvec; (void)w_ada; (void)b_ada; (void)g_pre_mix; (void)g_post_mix; (void)w_in; (void)rel_bias; (void)w_br_sb; (void)w_br_ca; (void)w_gate; (void)b_gate; (void)w_out; (void)g_pre_ffn; (void)g_post_ffn; \
    (void)w_router; (void)b_router; (void)w_e1; (void)b_e1; (void)w_e2; (void)b_e2; (void)out; (void)MOD; (void)WCAT; (void)WBR; (void)WOUT; (void)W1T; (void)W2T; (void)Hb; (void)QKVG; (void)GATES; (void)Ob; (void)TMP; \
    (void)MIXIN; (void)MIXED; (void)H2; (void)HID; (void)Yb; (void)ROWTOK; (void)SLOT; (void)gcnt; (void)x1o; (void)h2o; (void)rowtok_o; (void)slot_o; (void)gcnt_o
    gu32* const ctl0 = (gu32*)(args.ws + WS_CTL);
    for (int u = tid0; u < (LDS_BYTES - LDSCTL_OFF) / 4; u += NWAVES * 64) ((LAS unsigned*)(L + LDSCTL_OFF))[u] = 0u;
    __syncthreads();
    XcdBarrier bar; bar.bar = (unsigned*)(ctl0 + CW_BAR); bar.x = 0; bar.st = nullptr;
    if (N_LAUNCHES == 1) bar = xcd_barrier_post((unsigned*)(ctl0 + CW_BAR), (volatile LAS unsigned*)(L + LDSCTL_OFF));
    const int lo = args.ph_lo, hi_ph = args.ph_hi;
#define IN(k) (lo <= (k) && (k) < hi_ph)
#define SEAM(k) do { if (IN(k) && IN((k) + 1)) xcd_barrier(bar); } while (0)
    const int gw = vcu * NWAVES + wave, NGW = G * NWAVES;

    if (IN(0)) { PHASE_PTRS();
        LAS float* cl = (LAS float*)L;
        LAS float* red = (LAS float*)(L + 16384);
        for (int i = tid; i < BATCH * D; i += NWAVES * 64) cl[i] = cvec[i];
        __syncthreads();
        for (int t = bx; t < 192; t += G) {
            const int col = 32 * t + (lane & 31), sub = 2 * wave + (lane >> 5);
            float a0 = 0.f, a1 = 0.f, a2 = 0.f, a3 = 0.f;
            float wv_[64];
#pragma unroll
            for (int kk = 0; kk < 64; ++kk) wv_[kk] = __builtin_nontemporal_load(w_ada + (size_t)(64 * sub + kk) * 6144 + col);
#pragma unroll
            for (int kk = 0; kk < 64; ++kk) { const int k = 64 * sub + kk; const float w = wv_[kk];
                a0 += cl[k] * w; a1 += cl[1024 + k] * w; a2 += cl[2048 + k] * w; a3 += cl[3072 + k] * w; }
            red[(sub * 4 + 0) * 32 + (lane & 31)] = a0; red[(sub * 4 + 1) * 32 + (lane & 31)] = a1; red[(sub * 4 + 2) * 32 + (lane & 31)] = a2; red[(sub * 4 + 3) * 32 + (lane & 31)] = a3;
            __syncthreads();
            if (tid < 128) { const int b = tid >> 5, cc = tid & 31; float s = b_ada[32 * t + cc];
#pragma unroll
                for (int q = 0; q < 16; ++q) s += red[(q * 4 + b) * 32 + cc];
                MOD[b * 6144 + 32 * t + cc] = s; }
            __syncthreads();
        }
        __syncthreads();
        LAS float* scr = (LAS float*)(L + wave * 16640);
        constexpr int I0 = 16 * 48, I1 = 16 * 32, I2 = 8 * 16, I3 = 8 * 16, I4 = 16 * 16, I5 = NE * 16 * 32, I6 = NE * 16 * 16;
        constexpr int NITEMS = I0 + I1 + I2 + I3 + I4;
        for (int it = gw; it < NITEMS; it += NGW) {
            int r = it;
            if (r < I0) { const int kb = r / 48, nb = r % 48; cvt_block(w_in, 3072, 64 * kb, 64 * nb, WCAT, 1024, 64 * nb, 0, scr, lane); continue; } r -= I0;
            if (r < I1) { const int kb = r / 32, nb = r % 32; cvt_block8(w_gate, 2048, 64 * kb, 64 * nb, WG8, 1024, 64 * nb, scr, lane); continue; } r -= I1;
            if (r < I2) { const int kb = r / 16, nb = r % 16; cvt_block(w_br_sb, 1024, 64 * kb, 64 * nb, WBR, 1024, 64 * nb, 0, scr, lane); continue; } r -= I2;
            if (r < I3) { const int kb = r / 16, nb = r % 16; cvt_block(w_br_ca, 1024, 64 * kb, 64 * nb, WBR, 1024, 64 * nb, 512, scr, lane); continue; } r -= I3;
            { const int kb = r / 16, nb = r % 16; cvt_block8(w_out, 1024, 64 * kb, 64 * nb, (unsigned char*)WOUT, 1024, 64 * nb, scr, lane); }
        }
    }
    SEAM(0);

    if (IN(1)) { PHASE_PTRS();
        const int RPW = M / NGW;
        if (RPW * NGW == M && RPW >= 2 && (RPW & 1) == 0 && SEQ % RPW == 0) {
            const int unx = __builtin_amdgcn_readfirstlane((N_LAUNCHES == 1) ? (int)bar.st[2] : 0);
            const int gwx = unx ? (int)((bar.x * (unsigned)(G / 8) + __builtin_amdgcn_readfirstlane((int)bar.st[3])) * NWAVES) + wave : gw;
            const int m0 = gwx * RPW, mlast = m0 + RPW - 1, b = m0 / SEQ;
            f32x4 ca[4], cb[4];
#pragma unroll
            for (int j = 0; j < 4; ++j) { const int c = 4 * lane + 256 * j; const f32x4 gg = *(const f32x4*)(g_pre_mix + c), sc = *(const f32x4*)(MOD + b * 6144 + 1024 + c); ca[j] = gg * (sc + 1.0f); cb[j] = *(const f32x4*)(MOD + b * 6144 + c); }
#define P1_LOAD(v_, m_) do { _Pragma("unroll") for (int j = 0; j < 4; ++j) v_[j] = __builtin_nontemporal_load((const f32x4*)(x + (size_t)(m_) * D) + lane + 64 * j); } while (0)
#define P1_ROW(v_, m_) do { float s = 0.f; _Pragma("unroll") for (int j = 0; j < 4; ++j) s += (v_[j].x * v_[j].x + v_[j].y * v_[j].y) + (v_[j].z * v_[j].z + v_[j].w * v_[j].w); \
                const float rstd = 1.0f / sqrtf(wave_sum_fast(s) * (1.0f / D) + RMS_EPS); v2u* o8 = (v2u*)(Hb + (size_t)(m_) * D) + lane; \
                _Pragma("unroll") for (int j = 0; j < 4; ++j) { const f32x4 hv = v_[j] * rstd * ca[j] + cb[j]; v2u w; w.x = pk2(hv.x, hv.y); w.y = pk2(hv.z, hv.w); o8[64 * j] = w; \
                    ((unsigned*)(H8 + (size_t)(m_) * D) + lane)[64 * j] = pg8::cvt4_fp8(hv.x, hv.y, hv.z, hv.w); } } while (0)
            f32x4 va[4], vb[4];
            P1_LOAD(va, m0);
            for (int r = 0; r < RPW; r += 2) {
                P1_LOAD(vb, m0 + r + 1);
                __builtin_amdgcn_sched_barrier(0);
                P1_ROW(va, m0 + r);
                P1_LOAD(va, (m0 + r + 2 < mlast) ? m0 + r + 2 : mlast);
                __builtin_amdgcn_sched_barrier(0);
                P1_ROW(vb, m0 + r + 1);
            }
#undef P1_LOAD
#undef P1_ROW
        } else
        for (int b = 0; b < BATCH; ++b) {
            f32x4 ca[4], cb[4];
#pragma unroll
            for (int j = 0; j < 4; ++j) { const int c = 4 * lane + 256 * j; const f32x4 gg = *(const f32x4*)(g_pre_mix + c), sc = *(const f32x4*)(MOD + b * 6144 + 1024 + c); ca[j] = gg * (sc + 1.0f); cb[j] = *(const f32x4*)(MOD + b * 6144 + c); }
            for (int m = b * SEQ + gw; m < (b + 1) * SEQ; m += NGW) {
                const f32x4* xr = (const f32x4*)(x + (size_t)m * D) + lane; f32x4 v[4]; float s = 0.f;
#pragma unroll
                for (int j = 0; j < 4; ++j) { v[j] = __builtin_nontemporal_load(xr + 64 * j); s += (v[j].x * v[j].x + v[j].y * v[j].y) + (v[j].z * v[j].z + v[j].w * v[j].w); }
                const float rstd = 1.0f / sqrtf(wave_sum_fast(s) * (1.0f / D) + RMS_EPS);
                v2u* o8 = (v2u*)(Hb + (size_t)m * D) + lane;
#pragma unroll
                for (int j = 0; j < 4; ++j) { const f32x4 hv = v[j] * rstd * ca[j] + cb[j]; v2u w; w.x = pk2(hv.x, hv.y); w.y = pk2(hv.z, hv.w); o8[64 * j] = w;
                    ((unsigned*)(H8 + (size_t)m * D) + lane)[64 * j] = pg8::cvt4_fp8(hv.x, hv.y, hv.z, hv.w); }
            }
        }
    }
    if (IN(1) && IN(2)) { const int rpw_ = M / NGW; const bool fast_ = rpw_ * NGW == M && rpw_ >= 2 && (rpw_ & 1) == 0 && SEQ % rpw_ == 0 && rpw_ * NWAVES * (G / 8) * 8 == M;
        if (N_LAUNCHES == 1 && fast_ && __builtin_amdgcn_readfirstlane((int)bar.st[2])) xcd_local_barrier(bar); else xcd_barrier(bar); }

    if (IN(2)) { PHASE_PTRS();
        const int cx = __builtin_amdgcn_readfirstlane((N_LAUNCHES == 1 && bar.st[2]) ? (int)(bar.st[3] * 8u + bar.x) : bx);
        { pg8::Gemm g{Hb, WCAT, D, D, D, 128}; pg8::PlainOrder S{M / 256, 3072 / 256, G, cx, 256};
          pg8::EpiProj E{QKVG};
          pg8::gemm_phase<pg8::EpiProj, pg8::PlainOrder>(L, g, S, E); }
        { pg8::Gemm g{(const bf16*)H8, (const bf16*)WG8, D / 2, D / 2, D / 2, 128}; pg8::PlainOrder S{M / 256, 2048 / 256, G, cx, 256};
          pg8::EpiGate E{(unsigned char*)GATES, b_gate};
          pg8::gemm_phase<pg8::EpiGate, pg8::PlainOrder, 1>(L, g, S, E); }
    }
    SEAM(2);

    if (IN(3)) { PHASE_PTRS();
        LAS float* tb = (LAS float*)(L + att::LDS_TB);
        for (int i = tid; i < 8 * 321; i += NWAVES * 64) { const int hh = i / 321, j = i % 321; tb[hh * att::TBS + j] = rel_bias[hh * 513 + att::TB0 + j] * LOG2E; }
        if (tid < 32) ((LAS unsigned*)(L + att::LDS_FLAG))[tid] = 0u;
        __syncthreads();
        if (wave < 4) {
            att::GBar gb{(LAS unsigned*)(L + att::LDS_GBAR), 0u};
            att::OPend op{nullptr};
            const int amap = __builtin_amdgcn_readfirstlane((N_LAUNCHES == 1 && G == 256 && bar.st[2]) ? (int)(bar.x * 32u + bar.st[3]) : -1);
            att::ca_stream(QKVG, Ob, (LAS char*)L, wave, lane, gb, op, vcu, G, amap);
            att::sb_stream(QKVG, Ob, (LAS char*)L, wave, lane, gb, op, vcu, G, amap);
            att::flush_o((const att::bf16_t LAS*)(L + att::LDS_OST + wave * 4096), op, lane);
        } else {
            LAS float* scr = (LAS float*)(L + 96256 + (wave - 4) * 16640);
            constexpr int I5 = NE * 16 * 32, I6 = NE * 16 * 16;
            const int par = __builtin_amdgcn_readfirstlane((N_LAUNCHES == 1 && G == 256 && bar.st[2]) ? (int)(bar.x & 1u) : -1);
            int it0 = vcu * 4 + (wave - 4), itn = I5 + I6, its = G * 4;
            if (par >= 0) { const int w512 = __builtin_amdgcn_readfirstlane((int)(((bar.x >> 1) * 32u + bar.st[3]) * 4u)) + (wave - 4); its = 512; it0 = par ? 512 * CVT_NE + w512 : w512; itn = par ? I5 + I6 : 512 * CVT_NE; }
            for (int it = it0; it < itn; it += its) {
                int r = it;
                if (r < I5) { const int e = r / 512, q = r % 512, kb = q / 32, nb = q % 32; const int n0 = 64 * nb;
                    const int dr = (n0 < 1024) ? (256 * (n0 >> 7) + (n0 & 127)) : (256 * ((n0 - 1024) >> 7) + 128 + ((n0 - 1024) & 127));
                    cvt_block8(w_e1 + (size_t)e * 1024 * 2048, 2048, 64 * kb, n0, (unsigned char*)W1T, 1024, e * 2048 + dr, scr, lane); }
                else { r -= I5; const int e = r / 256, q = r % 256, kb = q / 16, nb = q % 16; cvt_block8(w_e2 + (size_t)e * 1024 * 1024, 1024, 64 * kb, 64 * nb, (unsigned char*)W2T, 1024, e * 1024 + 64 * nb, scr, lane); }
                if (par == 0) __builtin_amdgcn_s_sleep(CVT_SE); else if (par == 1) __builtin_amdgcn_s_sleep(CVT_SO); else __builtin_amdgcn_s_sleep(64);
            }
        }
        __syncthreads();
    }
    if (IN(3) && IN(4)) { if (N_LAUNCHES == 1 && G == 256 && __builtin_amdgcn_readfirstlane((int)bar.st[2])) xcd_local_barrier(bar); else xcd_barrier(bar); }

    if (IN(4)) { PHASE_PTRS();
        const int cx = __builtin_amdgcn_readfirstlane((N_LAUNCHES == 1 && bar.st[2]) ? (int)(bar.st[3] * 8u + bar.x) : bx);
        pg8::Gemm g{Ob, WBR, D, D, D, 0}; pg8::PlainOrder S{M / 256, D / 128, G, cx, 128};
        pg8::EpiMix2 E{GATES, MIXIN};
        pg8::gemm_phase<pg8::EpiMix2, pg8::PlainOrder, 2>(L, g, S, E);
    }
    if (IN(4) && IN(5)) { if (N_LAUNCHES == 1 && __builtin_amdgcn_readfirstlane((int)bar.st[2])) xcd_local_barrier(bar); else xcd_barrier(bar); }

    if (IN(5)) { PHASE_PTRS();
        const int cx = __builtin_amdgcn_readfirstlane((N_LAUNCHES == 1 && bar.st[2]) ? (int)(bar.st[3] * 8u + bar.x) : bx);
        pg8::Gemm g{MIXIN, WOUT, D / 2, D / 2, D / 2, 128}; pg8::PlainOrder S{M / 256, D / 256, G, cx, 256};
        pg8::EpiStore E{MIXED, D, nullptr, 1, 0, pg8::W8_INV, 0};
        pg8::gemm_phase<pg8::EpiStore, pg8::PlainOrder, 1>(L, g, S, E);
    }
    if (IN(5) && IN(6)) { if (N_LAUNCHES == 1 && G * 64 == M && __builtin_amdgcn_readfirstlane((int)bar.st[2])) xcd_local_barrier(bar); else xcd_barrier(bar); }

    if (IN(6)) { PHASE_PTRS();
        LAS float* wrT = (LAS float*)L;
        LAS float* lgs = (LAS float*)(L + 131584);
        LAS unsigned* lcnt = (LAS unsigned*)(L + 131584 + 8448);
        LAS unsigned* asg = (LAS unsigned*)(L + 131584 + 8448 + 256);
        { f32x4 wv[16];
#pragma unroll
          for (int k = 0; k < 16; ++k) wv[k] = *(const f32x4*)(w_router + 4 * (tid + 512 * k));
#pragma unroll
          for (int k = 0; k < 16; ++k) { const int i4 = tid + 512 * k, c = i4 >> 3, e4 = (i4 & 7) * 4; wrT[(e4 + 0) * 1028 + c] = wv[k].x; wrT[(e4 + 1) * 1028 + c] = wv[k].y; wrT[(e4 + 2) * 1028 + c] = wv[k].z; wrT[(e4 + 3) * 1028 + c] = wv[k].w; } }
        __syncthreads();
        const int ch0 = __builtin_amdgcn_readfirstlane((N_LAUNCHES == 1 && bar.st[2]) ? (int)(bar.x * (unsigned)(G / 8) + bar.st[3]) : bx);
        for (int ch = ch0; ch < M / 64; ch += G) {
            if (tid < 32) lcnt[tid] = 0u;
            const int b = (ch * 64) / SEQ;
            f32x4 pa[4], pb[4], pc[4];
#pragma unroll
            for (int j = 0; j < 4; ++j) { const int c = 4 * lane + 256 * j;
                pa[j] = *(const f32x4*)(g_post_mix + c) * *(const f32x4*)(MOD + b * 6144 + 2048 + c);
                pb[j] = *(const f32x4*)(g_pre_ffn + c) * (*(const f32x4*)(MOD + b * 6144 + 4096 + c) + 1.0f);
                pc[j] = *(const f32x4*)(MOD + b * 6144 + 3072 + c); }
            for (int rr = 0; rr < 8; rr += 2) {
                const int m = ch * 64 + wave * 8 + rr;
                v2u rm[2][4]; f32x4 rx[2][4];
#pragma unroll
                for (int q = 0; q < 2; ++q)
#pragma unroll
                    for (int j = 0; j < 4; ++j) { rm[q][j] = ((const v2u*)(MIXED + (size_t)(m + q) * D) + lane)[64 * j]; rx[q][j] = __builtin_nontemporal_load((const f32x4*)(x + (size_t)(m + q) * D) + lane + 64 * j); }
                f32x4 xv[2][4];
#pragma unroll
                for (int q = 0; q < 2; ++q) {
                    float s = 0.f, s2 = 0.f; f32x4 mx[4];
#pragma unroll
                    for (int j = 0; j < 4; ++j) { const v2u w = rm[q][j]; mx[j] = (f32x4){pg8::bf_lo(w.x), pg8::bf_hi(w.x), pg8::bf_lo(w.y), pg8::bf_hi(w.y)};
                        s += (mx[j].x * mx[j].x + mx[j].y * mx[j].y) + (mx[j].z * mx[j].z + mx[j].w * mx[j].w); }
                    const float rstd = 1.0f / sqrtf(wave_sum_fast(s) * (1.0f / D) + RMS_EPS);
#pragma unroll
                    for (int j = 0; j < 4; ++j) { xv[q][j] = rx[q][j] + pa[j] * (mx[j] * rstd); { v2u w_; w_.x = pk2(xv[q][j].x, xv[q][j].y); w_.y = pk2(xv[q][j].z, xv[q][j].w); ((v2u*)(X1 + (size_t)(m + q) * D) + lane)[64 * j] = w_; } s2 += (xv[q][j].x * xv[q][j].x + xv[q][j].y * xv[q][j].y) + (xv[q][j].z * xv[q][j].z + xv[q][j].w * xv[q][j].w); }
                    const float rstd2 = 1.0f / sqrtf(wave_sum_fast(s2) * (1.0f / D) + RMS_EPS);
                    unsigned* h2r = (unsigned*)((unsigned char*)h2o + (size_t)(m + q) * D) + lane;
#pragma unroll
                    for (int j = 0; j < 4; ++j) { xv[q][j] = xv[q][j] * rstd2 * pb[j] + pc[j]; h2r[64 * j] = pg8::cvt4_fp8(xv[q][j].x, xv[q][j].y, xv[q][j].z, xv[q][j].w); }
                }
                float pl[2][4];
#pragma unroll
                for (int k = 0; k < 4; ++k) {
                    float d8[2][8];
                    asm volatile("" ::: "memory");
#pragma unroll
                    for (int i = 0; i < 8; ++i) { const int e_ = k + 4 * i; pg8::f32x2 a2 = {0.f, 0.f}, b2 = {0.f, 0.f};
#pragma unroll
                        for (int j = 0; j < 4; ++j) { const f32x4 wv = *(const LAS f32x4*)(wrT + e_ * 1028 + 4 * lane + 256 * j);
                            a2 = __builtin_elementwise_fma((pg8::f32x2){xv[0][j].x, xv[0][j].y}, (pg8::f32x2){wv.x, wv.y}, a2); a2 = __builtin_elementwise_fma((pg8::f32x2){xv[0][j].z, xv[0][j].w}, (pg8::f32x2){wv.z, wv.w}, a2);
                            b2 = __builtin_elementwise_fma((pg8::f32x2){xv[1][j].x, xv[1][j].y}, (pg8::f32x2){wv.x, wv.y}, b2); b2 = __builtin_elementwise_fma((pg8::f32x2){xv[1][j].z, xv[1][j].w}, (pg8::f32x2){wv.z, wv.w}, b2); }
                        d8[0][i] = a2.x + a2.y; d8[1][i] = b2.x + b2.y; }
#pragma unroll
                    for (int q = 0; q < 2; ++q) {
#pragma unroll
                        for (int i = 0; i < 4; ++i) { auto r = __builtin_amdgcn_permlane32_swap(__float_as_uint(d8[q][i]), __float_as_uint(d8[q][i + 4]), false, false); d8[q][i] = __uint_as_float(r[0]) + __uint_as_float(r[1]); }
#pragma unroll
                        for (int i = 0; i < 2; ++i) { auto r = __builtin_amdgcn_permlane16_swap(__float_as_uint(d8[q][i]), __float_as_uint(d8[q][i + 2]), false, false); d8[q][i] = __uint_as_float(r[0]) + __uint_as_float(r[1]); }
                        { const bool up = (lane & 8) != 0; const float keep = up ? d8[q][1] : d8[q][0], send = up ? d8[q][0] : d8[q][1]; pl[q][k] = keep + dppf<0x140>(send); } }
                }
#pragma unroll
                for (int q = 0; q < 2; ++q) {
#define RSTEP(SB, N, CTL) _Pragma("unroll") for (int k = 0; k < N; ++k) { const bool up = (lane & SB) != 0; const float keep = up ? pl[q][k + N] : pl[q][k], send = up ? pl[q][k] : pl[q][k + N]; pl[q][k] = keep + dppf<CTL>(send); }
                    RSTEP(4, 2, 0x141) RSTEP(2, 1, 0x4E)
#undef RSTEP
                    const int e = (lane >> 1) & 31;
                    const float lg = pl[q][0] + dppf<0xB1>(pl[q][0]) + b_router[e];
                    if ((lane & 1) == 0) lgs[(wave * 8 + rr + q) * 33 + e] = lg; }
            }
            __syncthreads();
            {
                const int trow = tid >> 3, tj = tid & 7;
                float cv[4]; { const f32x4 c4 = {lgs[trow * 33 + 4 * tj], lgs[trow * 33 + 4 * tj + 1], lgs[trow * 33 + 4 * tj + 2], lgs[trow * 33 + 4 * tj + 3]}; cv[0] = c4.x; cv[1] = c4.y; cv[2] = c4.z; cv[3] = c4.w; }
                float tv[4]; int ti[4];
#pragma unroll
                for (int k = 0; k < 4; ++k) {
                    float bv = cv[0]; int bi = 4 * tj;
#pragma unroll
                    for (int i = 1; i < 4; ++i) if (cv[i] > bv) { bv = cv[i]; bi = 4 * tj + i; }
#define T4STEP(CTL) { const float pv_ = dppf<CTL>(bv); const int pi_ = __builtin_amdgcn_mov_dpp(bi, CTL, 0xF, 0xF, true); const bool tk = (pv_ > bv) || (pv_ == bv && pi_ < bi); bv = tk ? pv_ : bv; bi = tk ? pi_ : bi; }
                    T4STEP(0xB1) T4STEP(0x4E) T4STEP(0x141)
#undef T4STEP
                    tv[k] = bv; ti[k] = bi;
#pragma unroll
                    for (int i = 0; i < 4; ++i) cv[i] = (bi == 4 * tj + i) ? -3.0e38f : cv[i];
                }
                if (tj == 0) {
                    float ex[4], den = 0.f;
#pragma unroll
                    for (int k = 0; k < 4; ++k) { ex[k] = __builtin_amdgcn_exp2f((tv[k] - tv[0]) * LOG2E); den += ex[k]; }
                    const float inv = 1.0f / den;
#pragma unroll
                    for (int k = 0; k < 4; ++k) { const unsigned lp = atomicAdd((unsigned*)&lcnt[ti[k]], 1u); asg[(trow * 4 + k) * 2] = (unsigned)ti[k] | (lp << 8); asg[(trow * 4 + k) * 2 + 1] = __float_as_uint(ex[k] * inv); }
                }
            }
            __syncthreads();
            if (tid < 32) lcnt[32 + tid] = __hip_atomic_fetch_add(gcnt_o + 64 * tid, lcnt[tid], RLX_AGENT);
            __syncthreads();
            if (tid < 256) { const unsigned a = asg[tid * 2], wbits = asg[tid * 2 + 1]; const unsigned e = a & 255u, pos = lcnt[32 + e] + (a >> 8); const int m = ch * 64 + (tid >> 2);
                rowtok_o[e * CAP + pos] = m; v2u sl; sl.x = (e << 16) | pos; sl.y = wbits; slot_o[(size_t)m * 4 + (tid & 3)] = sl; }
            __syncthreads();
        }
    }
    SEAM(6);

    LAS int* mtab = (LAS int*)(L + MOETAB_OFF);
    if (IN(7) || IN(8) || IN(9)) { PHASE_PTRS();
        if (tid < 64) {
            const int e = tid & 31; const int cnt = (int)__hip_atomic_load(gcnt + 64 * e, RLX_AGENT); const int nb = (cnt + 255) >> 8;
            int inc = nb;
#pragma unroll
            for (int o = 1; o < 32; o <<= 1) { const int up = __shfl_up(inc, o, 32); if (e >= o) inc += up; }
            if (tid < 32) { mtab[80 + e] = cnt; mtab[e] = inc - nb; mtab[40 + e] = (inc - nb) * 256; if (e == 31) { mtab[32] = inc; mtab[72] = inc * 256; } }
        }
        __syncthreads();
    }

    if (IN(7)) { PHASE_PTRS();
        pg8::Gemm g{H2, W1T, D / 2, D / 2, D / 2, 128}; const int uni_ = __builtin_amdgcn_readfirstlane((N_LAUNCHES == 1) ? (int)bar.st[2] : 0), lx_ = uni_ ? (int)bar.x : -1, lr_ = __builtin_amdgcn_readfirstlane((int)bar.st[3]);
        pg8::MoeOrder<true> S{mtab, ROWTOK, 8, G, bx, (const LAS pg8::i32x4*)(L + pg8::UNIT_LDS), lx_, lr_, 0, uni_ ? (unsigned*)ctl + RBFLAG_W : nullptr}; S.build(tid);
        pg8::EpiSwiglu E{(unsigned char*)HID, b_e1};
        pg8::gemm_phase<pg8::EpiSwiglu, pg8::MoeOrder<true>, 1>(L, g, S, E);
    }
    if (IN(7) && IN(8)) { if (!(N_LAUNCHES == 1 && __builtin_amdgcn_readfirstlane((int)bar.st[2]))) xcd_barrier(bar); }

    if (IN(8)) { PHASE_PTRS();
        pg8::Gemm g{HID, W2T, D / 2, D / 2, D / 2, 128}; const int uni_ = __builtin_amdgcn_readfirstlane((N_LAUNCHES == 1) ? (int)bar.st[2] : 0), lx_ = uni_ ? (int)bar.x : -1, lr_ = __builtin_amdgcn_readfirstlane((int)bar.st[3]);
        pg8::MoeOrder<false> S{mtab, ROWTOK, 4, G, bx, (const LAS pg8::i32x4*)(L + pg8::UNIT_LDS), lx_, lr_, 8, uni_ ? (unsigned*)ctl + RBFLAG_W : nullptr}; S.build(tid);
        pg8::EpiStore E{Yb, D, b_e2, 256, 1024, pg8::W8_INV, 1};
        pg8::gemm_phase<pg8::EpiStore, pg8::MoeOrder<false>, 1>(L, g, S, E);
    }
    SEAM(8);

    if (IN(9)) { PHASE_PTRS();
        for (int b = 0; b < BATCH; ++b) {
            f32x4 pf[4];
#pragma unroll
            for (int j = 0; j < 4; ++j) { const int c = 4 * lane + 256 * j; pf[j] = *(const f32x4*)(g_post_ffn + c) * *(const f32x4*)(MOD + b * 6144 + 5120 + c); }
            for (int m = b * SEQ + gw; m < (b + 1) * SEQ; m += NGW) {
                v2u sl[4];
#pragma unroll
                for (int k = 0; k < 4; ++k) sl[k] = SLOT[(size_t)m * 4 + k];
                v2u rx[4];
#pragma unroll
                for (int j = 0; j < 4; ++j) rx[j] = __builtin_nontemporal_load((const v2u*)(X1 + (size_t)m * D) + lane + 64 * j);
                f32x4 ff[4];
#pragma unroll
                for (int j = 0; j < 4; ++j) ff[j] = (f32x4){0.f, 0.f, 0.f, 0.f};
#pragma unroll
                for (int k = 0; k < 4; ++k) { const int e = (int)(sl[k].x >> 16), pos = (int)(sl[k].x & 0xffffu); const float w = __uint_as_float(sl[k].y);
                    const int prow = mtab[40 + e] + pos; const unsigned char* yr = (const unsigned char*)Yb + (size_t)prow * D + (((lane >> 3) & 3) * 64 + ((lane >> 1) & 3) * 16 + ((lane >> 5) & 1) * 8 + (lane & 1) * 4);
#pragma unroll
                    for (int j = 0; j < 4; ++j) { const int u = (int)__builtin_nontemporal_load((const unsigned*)(yr + 256 * j)); const pg8::f32x2 lo = __builtin_amdgcn_cvt_pk_f32_fp8(u, false), hi2 = __builtin_amdgcn_cvt_pk_f32_fp8(u, true);
                        ff[j] += (f32x4){lo.x, lo.y, hi2.x, hi2.y} * w; } }
                float s = 0.f;
#pragma unroll
                for (int j = 0; j < 4; ++j) s += (ff[j].x * ff[j].x + ff[j].y * ff[j].y) + (ff[j].z * ff[j].z + ff[j].w * ff[j].w);
                const float rstd = 1.0f / sqrtf(wave_sum_fast(s) * (1.0f / D) + RMS_EPS);
                f32x4* orow = (f32x4*)(x1o + (size_t)m * D) + lane;
#pragma unroll
                for (int j = 0; j < 4; ++j) { const f32x4 x1 = {pg8::bf_lo(rx[j].x), pg8::bf_hi(rx[j].x), pg8::bf_lo(rx[j].y), pg8::bf_hi(rx[j].y)}; __builtin_nontemporal_store(x1 + pf[j] * (ff[j] * rstd), orow + 64 * j); }
            }
        }
    }
#undef IN
#undef SEAM
}

extern "C" void kernel_launch(void* const* d_in, const int* in_sizes, int n_in, void* d_out, int out_size, void* d_ws, size_t ws_size, hipStream_t stream) {
    static int grid = 0;
    if (grid == 0) {
        if (n_in != 21 || in_sizes[0] != M * D || out_size != M * D || ws_size < WS_END) { fprintf(stderr, "kernel_launch: unexpected shapes (n_in %d, in0 %d, out %d, ws %zu); nothing launched\n", n_in, n_in > 0 ? in_sizes[0] : -1, out_size, ws_size); grid = -1; return; }
        int dev = 0, cus = 0, per_cu = 0;
        if (hipGetDevice(&dev) != hipSuccess || hipDeviceGetAttribute(&cus, hipDeviceAttributeMultiprocessorCount, dev) != hipSuccess) { grid = -1; return; }
        if (hipFuncSetAttribute((const void*)mk_fwd, hipFuncAttributeMaxDynamicSharedMemorySize, LDS_BYTES) != hipSuccess) { fprintf(stderr, "kernel_launch: hipFuncSetAttribute failed\n"); grid = -1; return; }
        if (hipOccupancyMaxActiveBlocksPerMultiprocessor(&per_cu, (const void*)mk_fwd, NWAVES * 64, LDS_BYTES) != hipSuccess || per_cu < 1) { fprintf(stderr, "kernel_launch: occupancy query reports %d workgroups per CU\n", per_cu); per_cu = 1; }
        (void)hipGetLastError();
        grid = cus;
    }
    if (grid < 0) return;
    if (hipMemsetAsync((char*)d_ws + WS_CTL, 0, CTL_ZERO_BYTES, stream) != hipSuccess) { fprintf(stderr, "kernel_launch: memset failed\n"); return; }
    Args a{};
    for (int i = 0; i < 21; ++i) a.in[i] = (const float*)d_in[i];
    a.out = (float*)d_out; a.ws = (unsigned char*)d_ws;
    if (N_LAUNCHES == 1) {
        a.ph_lo = 0; a.ph_hi = N_PHASES; a.li = 0;
        void* kargs[] = {&a};
        hipError_t e = hipLaunchCooperativeKernel((const void*)mk_fwd, dim3(grid), dim3(NWAVES * 64), kargs, LDS_BYTES, stream);
        if (e != hipSuccess) fprintf(stderr, "kernel_launch: cooperative launch failed: %s (grid %d)\n", hipGetErrorString(e), grid);
        if (PROBE_REP >= 0) { Args a2 = a; a2.ph_lo = PROBE_REP; a2.ph_hi = PROBE_REP + 1; a2.li = 1; hipLaunchKernelGGL(mk_fwd, dim3(grid), dim3(NWAVES * 64), LDS_BYTES, stream, a2); }
    } else {
        for (int li = 0; li < N_PHASES; ++li) { a.ph_lo = li; a.ph_hi = li + 1; a.li = li; hipLaunchKernelGGL(mk_fwd, dim3(grid), dim3(NWAVES * 64), LDS_BYTES, stream, a); }
    }
}
```
